# Optimizing an MI355X kernel written in HIP

```python
import math
import jax
import jax.numpy as jnp
from jax import lax
import numpy as np

D_MODEL = 1024
BATCH = 4
SEQ = 4096
DEPTH = 1

GRID_W = 64
CTX_LEN = 256

MLA_HEADS = 8
MLA_NOPE = 64
MLA_ROPE = 32
MLA_QK = MLA_NOPE + MLA_ROPE
MLA_V = 64
Q_LORA = 256
KV_LORA = 128

SWA_HEADS = 8
SWA_KV_HEADS = 2
SWA_GROUP = SWA_HEADS // SWA_KV_HEADS
SWA_HD = 64
WINDOW = 128
BLOCK = 128

MIX_W = MLA_HEADS * MLA_V + SWA_HEADS * SWA_HD
IN_SIZES = (Q_LORA, KV_LORA, MLA_ROPE, SWA_HEADS * SWA_HD, SWA_KV_HEADS * SWA_HD, SWA_KV_HEADS * SWA_HD)
IN_W = Q_LORA + KV_LORA + MLA_ROPE + SWA_HEADS * SWA_HD + 2 * SWA_KV_HEADS * SWA_HD
D_FF = 4 * D_MODEL
ROPE_THETA = 10000.0
EPS = 1e-6
NEG_INF = -1e30
MLA_SCALE = 1.0 / math.sqrt(MLA_QK)
SWA_SCALE = 1.0 / math.sqrt(SWA_HD)

kernel_name = "hybrid_mla_swa_dit_block"


def rmsnorm(x, g):
    xf = x.astype(jnp.float32)
    y = xf * lax.rsqrt(jnp.mean(xf * xf, axis=-1, keepdims=True) + EPS)
    return (y * g.astype(jnp.float32)).astype(x.dtype)


def modulation(cond, w_mod, b_mod):
    m = jax.nn.silu(cond) @ w_mod + b_mod
    return jnp.split(m, 6, axis=-1)


def modulate(x, g, shift, scale):
    return rmsnorm(x, g) * (1.0 + scale) + shift


def axial_rope(rows, rot_dim):
    n_freq = rot_dim // 4
    inv = ROPE_THETA ** (-jnp.arange(n_freq, dtype=jnp.float32) / n_freq)
    row = jnp.repeat(jnp.arange(rows, dtype=jnp.float32), GRID_W)
    col = jnp.tile(jnp.arange(GRID_W, dtype=jnp.float32), rows)
    ang = jnp.concatenate([row[:, None] * inv, col[:, None] * inv], axis=-1)
    return jnp.cos(ang), jnp.sin(ang)


def apply_rope(x, cos, sin):
    half = x.shape[-1] // 2
    x1, x2 = x[..., :half], x[..., half:]
    c = cos[None, :, None, :].astype(x.dtype)
    s = sin[None, :, None, :].astype(x.dtype)
    return jnp.concatenate([x1 * c - x2 * s, x2 * c + x1 * s], axis=-1)


def project(h, w_in, g_q_a, w_uq, g_kv_a, w_ukv, g_mla_q, g_mla_k, g_swa_q, g_swa_k, rope):
    B, n, _ = h.shape
    z = h @ w_in
    offs = []
    acc = 0
    for sz in IN_SIZES[:-1]:
        acc += sz
        offs.append(acc)
    cq, ckv, kr, qs, ks, vs = jnp.split(z, offs, axis=-1)
    q_m = (rmsnorm(cq, g_q_a) @ w_uq).reshape(B, n, MLA_HEADS, MLA_QK)
    q_m = rmsnorm(q_m, g_mla_q)
    kv = (rmsnorm(ckv, g_kv_a) @ w_ukv).reshape(B, n, MLA_HEADS, MLA_NOPE + MLA_V)
    k_nope, v_m = kv[..., :MLA_NOPE], kv[..., MLA_NOPE:]
    k_rope = jnp.broadcast_to(kr[:, :, None, :], (B, n, MLA_HEADS, MLA_ROPE))
    k_m = rmsnorm(jnp.concatenate([k_nope, k_rope], axis=-1), g_mla_k)
    q_s = rmsnorm(qs.reshape(B, n, SWA_HEADS, SWA_HD), g_swa_q)
    k_s = rmsnorm(ks.reshape(B, n, SWA_KV_HEADS, SWA_HD), g_swa_k)
    v_s = vs.reshape(B, n, SWA_KV_HEADS, SWA_HD)
    if rope is not None:
        (cos_m, sin_m), (cos_s, sin_s) = rope
        q_m = jnp.concatenate([q_m[..., :MLA_NOPE], apply_rope(q_m[..., MLA_NOPE:], cos_m, sin_m)], axis=-1)
        k_m = jnp.concatenate([k_m[..., :MLA_NOPE], apply_rope(k_m[..., MLA_NOPE:], cos_m, sin_m)], axis=-1)
        q_s = apply_rope(q_s, cos_s, sin_s)
        k_s = apply_rope(k_s, cos_s, sin_s)
    return q_m, k_m, v_m, q_s, k_s, v_s


def mla_latent(q, k_lat, v_lat, k_ctx, v_ctx):
    B, S = q.shape[0], q.shape[1]
    nb = S // BLOCK
    k_all = jnp.concatenate([k_ctx, k_lat], axis=1)
    v_all = jnp.concatenate([v_ctx, v_lat], axis=1)
    qb = q.reshape(B, nb, BLOCK, MLA_HEADS, MLA_QK).transpose(1, 0, 2, 3, 4)

    def one_block(qblk):
        s = jnp.einsum('bqhd,bkhd->bhqk', qblk, k_all, preferred_element_type=jnp.float32) * MLA_SCALE
        p = jax.nn.softmax(s, axis=-1).astype(v_all.dtype)
        return jnp.einsum('bhqk,bkhd->bqhd', p, v_all)

    out = lax.map(one_block, qb)
    return out.transpose(1, 0, 2, 3, 4).reshape(B, S, MLA_HEADS * MLA_V)


def mla_context(q, k, v):
    B, n = q.shape[0], q.shape[1]
    s = jnp.einsum('bqhd,bkhd->bhqk', q, k, preferred_element_type=jnp.float32) * MLA_SCALE
    p = jax.nn.softmax(s, axis=-1).astype(v.dtype)
    return jnp.einsum('bhqk,bkhd->bqhd', p, v).reshape(B, n, MLA_HEADS * MLA_V)


def swa_latent(q, k, v, k_ctx, v_ctx, sink):
    B, S = q.shape[0], q.shape[1]
    nb = S // BLOCK
    n_ctx = k_ctx.shape[1]
    qb = q.reshape(B, nb, BLOCK, SWA_KV_HEADS, SWA_GROUP, SWA_HD)
    pad = ((0, 0), (BLOCK, BLOCK), (0, 0), (0, 0))
    kp = jnp.pad(k, pad).reshape(B, nb + 2, BLOCK, SWA_KV_HEADS, SWA_HD)
    vp = jnp.pad(v, pad).reshape(B, nb + 2, BLOCK, SWA_KV_HEADS, SWA_HD)
    kband = jnp.concatenate([kp[:, :-2], kp[:, 1:-1], kp[:, 2:]], axis=2)
    vband = jnp.concatenate([vp[:, :-2], vp[:, 1:-1], vp[:, 2:]], axis=2)
    blk = jnp.arange(nb)[:, None] * BLOCK
    qpos = blk + jnp.arange(BLOCK)[None, :]
    kpos = blk - BLOCK + jnp.arange(3 * BLOCK)[None, :]
    valid = ((jnp.abs(qpos[:, :, None] - kpos[:, None, :]) <= WINDOW)
             & (kpos[:, None, :] >= 0) & (kpos[:, None, :] < S))
    s_band = jnp.einsum('bnqhgd,bnkhd->bnhgqk', qb, kband, preferred_element_type=jnp.float32) * SWA_SCALE
    s_band = jnp.where(valid[None, :, None, None], s_band, NEG_INF)
    s_ctx = jnp.einsum('bnqhgd,bkhd->bnhgqk', qb, k_ctx, preferred_element_type=jnp.float32) * SWA_SCALE
    s_sink = jnp.broadcast_to(
        sink.astype(jnp.float32).reshape(SWA_KV_HEADS, SWA_GROUP)[None, None, :, :, None, None],
        s_band.shape[:-1] + (1,))
    p = jax.nn.softmax(jnp.concatenate([s_band, s_ctx, s_sink], axis=-1), axis=-1)
    p_band = p[..., :3 * BLOCK].astype(v.dtype)
    p_ctx = p[..., 3 * BLOCK:3 * BLOCK + n_ctx].astype(v.dtype)
    out = (jnp.einsum('bnhgqk,bnkhd->bnqhgd', p_band, vband)
           + jnp.einsum('bnhgqk,bkhd->bnqhgd', p_ctx, v_ctx))
    return out.reshape(B, S, SWA_HEADS * SWA_HD)


def swa_context(q, k, v, sink):
    B, n = q.shape[0], q.shape[1]
    qg = q.reshape(B, n, SWA_KV_HEADS, SWA_GROUP, SWA_HD)
    s = jnp.einsum('bqhgd,bkhd->bhgqk', qg, k, preferred_element_type=jnp.float32) * SWA_SCALE
    s_sink = jnp.broadcast_to(
        sink.astype(jnp.float32).reshape(SWA_KV_HEADS, SWA_GROUP)[None, :, :, None, None],
        s.shape[:-1] + (1,))
    p = jax.nn.softmax(jnp.concatenate([s, s_sink], axis=-1), axis=-1)[..., :n].astype(v.dtype)
    return jnp.einsum('bhgqk,bkhd->bqhgd', p, v).reshape(B, n, SWA_HEADS * SWA_HD)


def squared_relu_mlp(h, w1, w2):
    a = jax.nn.relu(h @ w1)
    return (a * a) @ w2


def setup_inputs(seed: int = 0) -> dict:
    key = jax.random.key(seed)
    ks = jax.random.split(key, 24)
    f32 = jnp.float32

    def w(k, shape, fan_in):
        return jax.random.normal(k, shape, f32) * (fan_in ** -0.5)

    def gain(k, shape):
        return 1.0 + 0.1 * jax.random.normal(k, shape, f32)

    L = DEPTH
    return {
        "x": jax.random.normal(ks[0], (BATCH, SEQ, D_MODEL), f32),
        "c": jax.random.normal(ks[1], (BATCH, D_MODEL), f32),
        "ctx": jax.random.normal(ks[2], (BATCH, CTX_LEN, D_MODEL), f32),
        "c_ctx": jax.random.normal(ks[3], (D_MODEL,), f32),
        "w_mod": w(ks[4], (L, D_MODEL, 6 * D_MODEL), D_MODEL),
        "b_mod": 0.01 * jax.random.normal(ks[5], (L, 6 * D_MODEL), f32),
        "g_attn": gain(ks[6], (L, D_MODEL)),
        "w_in": w(ks[7], (L, D_MODEL, IN_W), D_MODEL),
        "g_q_a": gain(ks[8], (L, Q_LORA)),
        "w_uq": w(ks[9], (L, Q_LORA, MLA_HEADS * MLA_QK), Q_LORA),
        "g_kv_a": gain(ks[10], (L, KV_LORA)),
        "w_ukv": w(ks[11], (L, KV_LORA, MLA_HEADS * (MLA_NOPE + MLA_V)), KV_LORA),
        "g_mla_q": gain(ks[12], (L, MLA_QK)),
        "g_mla_k": gain(ks[13], (L, MLA_QK)),
        "g_swa_q": gain(ks[14], (L, SWA_HD)),
        "g_swa_k": gain(ks[15], (L, SWA_HD)),
        "swa_sink": 0.5 * jax.random.normal(ks[16], (L, SWA_HEADS), f32),
        "w_out": w(ks[17], (L, MIX_W, D_MODEL), MIX_W),
        "g_mlp": gain(ks[18], (L, D_MODEL)),
        "w_mlp1": w(ks[19], (L, D_MODEL, D_FF), D_MODEL),
        "w_mlp2": w(ks[20], (L, D_FF, D_MODEL), D_FF),
    }


def reference(x, c, ctx, c_ctx, w_mod, b_mod, g_attn, w_in, g_q_a, w_uq, g_kv_a, w_ukv,
              g_mla_q, g_mla_k, g_swa_q, g_swa_k, swa_sink, w_out, g_mlp, w_mlp1, w_mlp2):
    rows = x.shape[1] // GRID_W
    rope = (axial_rope(rows, MLA_ROPE), axial_rope(rows, SWA_HD))

    for i in range(DEPTH):
        sh1, sc1, g1, sh2, sc2, g2 = [m[:, None, :] for m in modulation(c, w_mod[i], b_mod[i])]
        csh1, csc1, cg1, csh2, csc2, cg2 = modulation(c_ctx, w_mod[i], b_mod[i])

        h_lat = modulate(x, g_attn[i], sh1, sc1)
        h_ctx = modulate(ctx, g_attn[i], csh1, csc1)
        proj_args = (w_in[i], g_q_a[i], w_uq[i], g_kv_a[i], w_ukv[i],
                     g_mla_q[i], g_mla_k[i], g_swa_q[i], g_swa_k[i])
        qm_l, km_l, vm_l, qs_l, ks_l, vs_l = project(h_lat, *proj_args, rope)
        qm_c, km_c, vm_c, qs_c, ks_c, vs_c = project(h_ctx, *proj_args, None)

        mix_lat = jnp.concatenate([
            mla_latent(qm_l, km_l, vm_l, km_c, vm_c),
            swa_latent(qs_l, ks_l, vs_l, ks_c, vs_c, swa_sink[i]),
        ], axis=-1)
        x = x + g1 * (mix_lat @ w_out[i])
        x = x + g2 * squared_relu_mlp(modulate(x, g_mlp[i], sh2, sc2), w_mlp1[i], w_mlp2[i])

        if i + 1 < DEPTH:
            mix_ctx = jnp.concatenate([
                mla_context(qm_c, km_c, vm_c),
                swa_context(qs_c, ks_c, vs_c, swa_sink[i]),
            ], axis=-1)
            ctx = ctx + cg1 * (mix_ctx @ w_out[i])
            ctx = ctx + cg2 * squared_relu_mlp(modulate(ctx, g_mlp[i], csh2, csc2), w_mlp1[i], w_mlp2[i])

    return x
```

```cpp
#include <hip/hip_runtime.h>
#include <cstdio>
#include <cstdint>

#ifndef MK_N_LAUNCHES
#define MK_N_LAUNCHES 1
#endif

constexpr int D = 1024, NB = 4, SEQ = 4096, NCTX = 256, GRIDW = 64;
constexpr int ML = NB * SEQ;
constexpr int MC = NB * NCTX;
constexpr int MA = ML + MC;
constexpr int NKEY = NCTX + SEQ;
constexpr int INW = 1184, INWP = 1280;
constexpr int QLORA = 256, KVLORA = 128;
constexpr int MH = 8, MQK = 96, MNOPE = 64, MROPE = 32, MV = 64;
constexpr int SH = 8, SKV = 2, SHD = 64;
constexpr int FF = 4096;
constexpr int Z_CQ = 0, Z_CKV = 256, Z_KR = 384, Z_QS = 416, Z_KS = 928, Z_VS = 1056;
constexpr float EPS = 1e-6f;
constexpr float LOG2E = 1.4426950408889634f;
constexpr float MLA_C = 0.10206207261596577f * LOG2E;
constexpr float SWA_C = 0.125f * LOG2E;
constexpr int NWAVES = 8, NTHREADS = 512;

constexpr size_t MiB = 1u << 20;
constexpr size_t WS_CTL = 0, CTL_ZERO_BYTES = 1 * MiB;
constexpr size_t WS_MODF = 1 * MiB;
constexpr size_t WS_ROPE = 1 * MiB + 256 * 1024;
constexpr size_t WS_WIN = 3 * MiB;
constexpr size_t WS_WUQ = 6 * MiB;
constexpr size_t WS_WUKV = 7 * MiB;
constexpr size_t WS_WOUT = 8 * MiB;
constexpr size_t WS_W1 = 10 * MiB;
constexpr size_t WS_W2 = 18 * MiB;
constexpr size_t WS_H = 26 * MiB;
constexpr size_t WS_Z = 60 * MiB;
constexpr size_t WS_A1Q = 103 * MiB;
constexpr size_t WS_A1KV = 111 * MiB;
constexpr size_t WS_QM = 116 * MiB;
constexpr size_t WS_KM = 140 * MiB;
constexpr size_t WS_VM = 166 * MiB;
constexpr size_t WS_QS = 183 * MiB;
constexpr size_t WS_KS = 199 * MiB;
constexpr size_t WS_VS = 204 * MiB;
constexpr size_t WS_KVRAW = 209 * MiB;
constexpr size_t WS_ACT = 60 * MiB;
constexpr size_t WS_END = 256 * MiB;
static_assert(WS_KVRAW + (size_t)MA * 1024 * 2 <= WS_END && WS_ACT + (size_t)ML * FF * 2 <= WS_KVRAW, "ws map");

constexpr int CW_BAR = 4096;

constexpr int LDS_BYTES = 147456;
constexpr int MISC_OFF = 131072 + 320;

#define GAS __attribute__((address_space(1)))
#define LAS __attribute__((address_space(3)))
typedef unsigned short bf16_t;
typedef unsigned v4u __attribute__((ext_vector_type(4)));
typedef unsigned v2u __attribute__((ext_vector_type(2)));
typedef float f32x4 __attribute__((ext_vector_type(4)));
typedef short bf16x8 __attribute__((ext_vector_type(8)));

__device__ __forceinline__ unsigned f2bf(float f) { unsigned u = __builtin_bit_cast(unsigned, f); return (u + 0x7fffu + ((u >> 16) & 1u)) >> 16; }
__device__ __forceinline__ unsigned pk2(float lo, float hi) { return f2bf(lo) | (f2bf(hi) << 16); }
__device__ __forceinline__ float bflo(unsigned w) { return __builtin_bit_cast(float, w << 16); }
__device__ __forceinline__ float bfhi(unsigned w) { return __builtin_bit_cast(float, w & 0xffff0000u); }
__device__ __forceinline__ float bf2f(bf16_t h) { return __builtin_bit_cast(float, (unsigned)h << 16); }
__device__ __forceinline__ float wave_sum(float v) {
#pragma unroll
    for (int o = 1; o < 64; o <<= 1) v += __shfl_xor(v, o);
    return v;
}

#define XB_TMO      128
#define XB_XCNT(j)  (256  + 64 * (j))
#define XB_XSUB(j)  (1280 + 64 * (j))
#define XB_XGEN(j)  (2304 + 64 * (j))
#define XB_TOP      3328
#define XB_TOPGEN   3392
#define XCD_BAR_WORDS 3456
#define XB_SPIN_CAP (1u << 18)
__device__ __forceinline__ unsigned xb_ld(unsigned* p)              { return __hip_atomic_load(p, __ATOMIC_RELAXED, __HIP_MEMORY_SCOPE_AGENT); }
__device__ __forceinline__ unsigned xb_add(unsigned* p, unsigned v) { return __hip_atomic_fetch_add(p, v, __ATOMIC_RELAXED, __HIP_MEMORY_SCOPE_AGENT); }
__device__ __forceinline__ unsigned xb_xcc_id() { return (unsigned)__builtin_amdgcn_s_getreg((3 << 11) | 20) & 0xFu; }
#define XB_SPIN(cond, bar) do { unsigned _sp = 0; while (cond) { __builtin_amdgcn_s_sleep(1); \
    if ((++_sp & 255u) == 0u) { if (xb_ld(&(bar)[XB_TMO])) break; if (_sp > XB_SPIN_CAP) { atomicAdd(&(bar)[XB_TMO], 1u); break; } } } } while (0)
struct XcdBarrier { unsigned* bar; unsigned x; volatile LAS unsigned* st; };
__device__ __forceinline__ XcdBarrier xcd_barrier_post(unsigned* bar, volatile LAS unsigned* st) {
    XcdBarrier b; b.bar = bar; b.x = xb_xcc_id(); b.st = st;
    if (threadIdx.x == 0) (void)xb_add(&bar[XB_XCNT(b.x)], 1u);
    return b;
}
__device__ __forceinline__ void xcd_barrier_complete(unsigned* bar, unsigned x, unsigned& nloc, unsigned& nx) {
    const unsigned G = gridDim.x * gridDim.y * gridDim.z;
    unsigned sum, cnt, mine, sp = 0u;
    for (;;) {
        sum = 0u; cnt = 0u; mine = 0u;
#pragma unroll
        for (unsigned j = 0; j < 16; ++j) { const unsigned c = xb_ld(&bar[XB_XCNT(j)]); sum += c; cnt += (c > 0u) ? 1u : 0u; mine = (j == x) ? c : mine; }
        if (sum == G) break;
        __builtin_amdgcn_s_sleep(1);
        if ((++sp & 255u) == 0u) { if (xb_ld(&bar[XB_TMO])) break; if (sp > XB_SPIN_CAP) { atomicAdd(&bar[XB_TMO], 1u); break; } }
    }
    nloc = mine > 0u ? mine : 1u; nx = cnt > 0u ? cnt : 1u;
}
__device__ __forceinline__ void xcd_barrier(const XcdBarrier& b) {
    asm volatile("s_waitcnt vmcnt(0)" ::: "memory");
    __syncthreads();
    if (threadIdx.x == 0) {
        unsigned* bar = b.bar;
        __builtin_amdgcn_s_waitcnt(0);
        unsigned nloc = b.st[0], nx = b.st[1];
        if (nloc == 0u) { xcd_barrier_complete(bar, b.x, nloc, nx); b.st[0] = nloc; b.st[1] = nx; }
        const unsigned old = xb_add(&bar[XB_XSUB(b.x)], 1u);
        const unsigned gen = old / nloc;
        if (old + 1u == (gen + 1u) * nloc) {
            __builtin_amdgcn_fence(__ATOMIC_RELEASE, "agent");
            asm volatile("s_waitcnt vmcnt(0)" ::: "memory");
            const unsigned og = xb_add(&bar[XB_TOP], 1u);
            const unsigned tg = og / nx;
            if (og + 1u == (tg + 1u) * nx) xb_add(&bar[XB_TOPGEN], 1u);
            else XB_SPIN(xb_ld(&bar[XB_TOPGEN]) == tg, bar);
            __builtin_amdgcn_fence(__ATOMIC_ACQUIRE, "agent");
            xb_add(&bar[XB_XGEN(b.x)], 1u);
            asm volatile("s_waitcnt vmcnt(0)" ::: "memory");
        } else {
            XB_SPIN(xb_ld(&bar[XB_XGEN(b.x)]) == gen, bar);
            __builtin_amdgcn_fence(__ATOMIC_ACQUIRE, "agent");
            asm volatile("s_waitcnt vmcnt(0)" ::: "memory");
        }
    }
    __syncthreads();
}

struct Args { const float* in[21]; float* out; unsigned char* ws; int ph_lo, ph_hi; };
struct Frame {
    LAS unsigned char* lds;
    int tid, lane, wave, G, bid, gw, ngw;
    const float *x, *c, *ctx, *c_ctx, *w_mod, *b_mod, *g_attn, *w_in, *g_q_a, *w_uq, *g_kv_a, *w_ukv, *g_mla_q, *g_mla_k, *g_swa_q, *g_swa_k, *swa_sink, *w_out, *g_mlp, *w_mlp1, *w_mlp2;
    float* out;
    float* modf; float *cosS, *sinS, *cosM, *sinM;
    bf16_t *Win_t, *Wuq_t, *Wukv_t, *Wout_t, *W1_t, *W2_t;
    bf16_t *H, *Z, *A1q, *A1kv, *QMraw, *KVraw, *QM, *KM, *VM, *QS, *KS, *VS, *MIX, *H2, *ACT;
};

template <class Epi>
__device__ __forceinline__ void sgemm_phase(const bf16_t* A, int lda, const bf16_t* Bt, int ldb, int M, int N, int K, int gw, int ngw, int lane, const Epi& E) {
    const int tm = M / 64, tn = (N + 63) / 64, fr = lane & 15, fq = lane >> 4;
    for (int t = gw; t < tm * tn; t += ngw) {
        const int pm = t / tn, pn = t % tn;
        f32x4 acc[4][4];
#pragma unroll
        for (int i = 0; i < 4; ++i)
#pragma unroll
            for (int j = 0; j < 4; ++j) acc[i][j] = (f32x4){0.f, 0.f, 0.f, 0.f};
        const bf16_t* ap = A + (size_t)(pm * 64 + fr) * lda + 8 * fq;
        const bf16_t* bp = Bt + (size_t)(pn * 64 + fr) * ldb + 8 * fq;
        for (int k = 0; k < K; k += 32) {
            bf16x8 a[4], b[4];
#pragma unroll
            for (int i = 0; i < 4; ++i) a[i] = *(const bf16x8*)(ap + (size_t)i * 16 * lda + k);
#pragma unroll
            for (int j = 0; j < 4; ++j) b[j] = *(const bf16x8*)(bp + (size_t)j * 16 * ldb + k);
#pragma unroll
            for (int i = 0; i < 4; ++i)
#pragma unroll
                for (int j = 0; j < 4; ++j) acc[i][j] = __builtin_amdgcn_mfma_f32_16x16x32_bf16(b[j], a[i], acc[i][j], 0, 0, 0);
        }
#pragma unroll
        for (int i = 0; i < 4; ++i)
#pragma unroll
            for (int j = 0; j < 4; ++j) E(pm * 64 + i * 16 + fr, pn * 64 + j * 16 + 4 * fq, acc[i][j]);
    }
}
struct EpiStoreBf16 { bf16_t* O; int ldc; int ncols;
    __device__ __forceinline__ void operator()(int row, int col, f32x4 v) const { if (col < ncols) { v2u w; w.x = pk2(v[0], v[1]); w.y = pk2(v[2], v[3]); *(v2u*)(O + (size_t)row * ldc + col) = w; } } };
struct EpiRelu2 { bf16_t* O; int ldc;
    __device__ __forceinline__ void operator()(int row, int col, f32x4 v) const { f32x4 r; for (int i = 0; i < 4; ++i) { float t = v[i] > 0.f ? v[i] : 0.f; r[i] = t * t; } v2u w; w.x = pk2(r[0], r[1]); w.y = pk2(r[2], r[3]); *(v2u*)(O + (size_t)row * ldc + col) = w; } };
struct EpiGateRes { const float* base; float* out; const float* gate  ;
    __device__ __forceinline__ void operator()(int row, int col, f32x4 v) const { const int b = row >> 12; const f32x4 g = *(const f32x4*)(gate + (size_t)b * 6144 + col); const f32x4 x0 = *(const f32x4*)(base + (size_t)row * D + col);
        *(f32x4*)(out + (size_t)row * D + col) = x0 + g * v; } };

__device__ __forceinline__ void p0_transpose_item(const float* W, int K, int N, bf16_t* WT, LAS float* scr, int item, int lane) {
    const int nblk = N / 32, kb = item / nblk, nb = item % nblk, k0 = 64 * kb, n0 = 32 * nb;
#pragma unroll 8
    for (int i = 0; i < 32; ++i) { const int kk = 2 * i + (lane >> 5); scr[kk * 33 + (lane & 31)] = W[(size_t)(k0 + kk) * N + n0 + (lane & 31)]; }
    asm volatile("s_waitcnt lgkmcnt(0)" ::: "memory");
    const int c = lane & 7;
#pragma unroll
    for (int j = 0; j < 4; ++j) { const int n = (lane >> 3) + 8 * j; const LAS float* s = scr + (8 * c) * 33 + n;
        v4u o; o.x = pk2(s[0 * 33], s[1 * 33]); o.y = pk2(s[2 * 33], s[3 * 33]); o.z = pk2(s[4 * 33], s[5 * 33]); o.w = pk2(s[6 * 33], s[7 * 33]);
        *(v4u*)(WT + (size_t)(n0 + n) * K + k0 + 8 * c) = o; }
    asm volatile("s_waitcnt lgkmcnt(0)" ::: "memory");
}
__device__ __forceinline__ void sincos_d(float ang, float& sn, float& cs) {
    const double x = (double)ang; const double n = __builtin_rint(x * 0.63661977236758134308); const double r = x - n * 1.57079632679489661923;
    const double r2 = r * r;
    const double s = r * (1.0 + r2 * (-1.0 / 6 + r2 * (1.0 / 120 + r2 * (-1.0 / 5040 + r2 * (1.0 / 362880 + r2 * (-1.0 / 39916800 + r2 * (1.0 / 6227020800.0)))))));
    const double c = 1.0 + r2 * (-0.5 + r2 * (1.0 / 24 + r2 * (-1.0 / 720 + r2 * (1.0 / 40320 + r2 * (-1.0 / 3628800 + r2 * (1.0 / 479001600.0))))));
    const int q = ((int)n) & 3;
    const double ss = (q == 0) ? s : (q == 1) ? c : (q == 2) ? -s : -c;
    const double cc = (q == 0) ? c : (q == 1) ? -s : (q == 2) ? -c : s;
    sn = (float)ss; cs = (float)cc;
}
__device__ __forceinline__ void phase0(Frame& F) {
    LAS float* scr = (LAS float*)(F.lds + F.wave * 16384);
    constexpr int I_IN = (D / 64) * (INW / 32), I_UQ = (QLORA / 64) * (768 / 32), I_UKV = (KVLORA / 64) * (1024 / 32), I_OUT = (D / 64) * (D / 32), I_1 = (D / 64) * (FF / 32), I_2 = (FF / 64) * (D / 32);
    constexpr int NITEMS = I_IN + I_UQ + I_UKV + I_OUT + I_1 + I_2;
    for (int it = F.gw; it < NITEMS; it += F.ngw) {
        int r = it;
        if (r < I_IN) { p0_transpose_item(F.w_in, D, INW, F.Win_t, scr, r, F.lane); continue; } r -= I_IN;
        if (r < I_UQ) { p0_transpose_item(F.w_uq, QLORA, 768, F.Wuq_t, scr, r, F.lane); continue; } r -= I_UQ;
        if (r < I_UKV) { p0_transpose_item(F.w_ukv, KVLORA, 1024, F.Wukv_t, scr, r, F.lane); continue; } r -= I_UKV;
        if (r < I_OUT) { p0_transpose_item(F.w_out, D, D, F.Wout_t, scr, r, F.lane); continue; } r -= I_OUT;
        if (r < I_1) { p0_transpose_item(F.w_mlp1, D, FF, F.W1_t, scr, r, F.lane); continue; } r -= I_1;
        p0_transpose_item(F.w_mlp2, FF, D, F.W2_t, scr, r, F.lane);
    }
    { const int gt = F.bid * NTHREADS + F.tid, ngt = F.G * NTHREADS; v4u z = (v4u){0u, 0u, 0u, 0u};
      for (int i = gt; i < (INWP - INW) * D / 8; i += ngt) *(v4u*)(F.Win_t + (size_t)INW * D + (size_t)i * 8) = z; }
    { const int gt = F.bid * NTHREADS + F.tid, ngt = F.G * NTHREADS;
      for (int i = gt; i < SEQ * 32; i += ngt) { const int s = i >> 5, j = i & 31; const int row = s >> 6, col = s & 63; const int f = j & 15;
          const float inv = powf(10000.0f, -(float)f / 16.0f); const float ang = (j < 16 ? (float)row : (float)col) * inv; float sn, cs; sincos_d(ang, sn, cs); F.cosS[i] = cs; F.sinS[i] = sn; }
      for (int i = gt; i < SEQ * 16; i += ngt) { const int s = i >> 4, j = i & 15; const int row = s >> 6, col = s & 63; const int f = j & 7;
          const float inv = powf(10000.0f, -(float)f / 8.0f); const float ang = (j < 8 ? (float)row : (float)col) * inv; float sn, cs; sincos_d(ang, sn, cs); F.cosM[i] = cs; F.sinM[i] = sn; } }
    __syncthreads();
    if (F.bid < 96) {
        LAS float* sl = (LAS float*)F.lds;
        LAS float* red = sl + 5 * 1024;
        for (int i = F.tid; i < 5 * 1024; i += NTHREADS) { const int r = i >> 10, k = i & 1023; const float v = (r < 4) ? F.c[r * 1024 + k] : F.c_ctx[k]; sl[i] = v / (1.0f + __expf(-v)); }
        __syncthreads();
        const int col = F.bid * 64 + F.lane; float a0 = 0.f, a1 = 0.f, a2 = 0.f, a3 = 0.f, a4 = 0.f;
        const int kb = F.wave * 128;
#pragma unroll 8
        for (int k = kb; k < kb + 128; ++k) { const float w = F.w_mod[(size_t)k * 6144 + col];
            a0 += sl[k] * w; a1 += sl[1024 + k] * w; a2 += sl[2048 + k] * w; a3 += sl[3072 + k] * w; a4 += sl[4096 + k] * w; }
        red[(F.wave * 5 + 0) * 64 + F.lane] = a0; red[(F.wave * 5 + 1) * 64 + F.lane] = a1; red[(F.wave * 5 + 2) * 64 + F.lane] = a2; red[(F.wave * 5 + 3) * 64 + F.lane] = a3; red[(F.wave * 5 + 4) * 64 + F.lane] = a4;
        __syncthreads();
        if (F.tid < 320) { const int r = F.tid >> 6, l = F.tid & 63; float s = 0.f;
#pragma unroll
            for (int w = 0; w < 8; ++w) s += red[(w * 5 + r) * 64 + l];
            F.modf[r * 6144 + F.bid * 64 + l] = s + F.b_mod[F.bid * 64 + l]; }
    }
    __syncthreads();
}

__device__ __forceinline__ void modulate_row(const float* xrow, const float* g, const float* shift, const float* scale, bf16_t* orow, int lane) {
    const f32x4* xr = (const f32x4*)xrow + lane;
    f32x4 v[4]; float s = 0.f;
#pragma unroll
    for (int j = 0; j < 4; ++j) { v[j] = xr[64 * j]; s += (v[j].x * v[j].x + v[j].y * v[j].y) + (v[j].z * v[j].z + v[j].w * v[j].w); }
    const float rstd = 1.0f / sqrtf(wave_sum(s) * (1.f / D) + EPS);
    v2u* o8 = (v2u*)orow + lane;
#pragma unroll
    for (int j = 0; j < 4; ++j) { const int c = 4 * lane + 256 * j; const f32x4 gg = *(const f32x4*)(g + c), sh = *(const f32x4*)(shift + c), sc = *(const f32x4*)(scale + c);
        const f32x4 y = v[j] * rstd * gg * (1.0f + sc) + sh; v2u w; w.x = pk2(y.x, y.y); w.y = pk2(y.z, y.w); o8[64 * j] = w; }
}
__device__ __forceinline__ void phase1(Frame& F) {
    for (int m = F.gw; m < MA; m += F.ngw) {
        const bool lat = m < ML; const int r = lat ? (m >> 12) : 4;
        const float* src = lat ? F.x + (size_t)m * D : F.ctx + (size_t)(m - ML) * D;
        modulate_row(src, F.g_attn, F.modf + r * 6144, F.modf + r * 6144 + 1024, F.H + (size_t)m * D, F.lane);
    }
}
__device__ __forceinline__ void phase8(Frame& F) {
    for (int m = F.gw; m < ML; m += F.ngw) { const int r = m >> 12;
        modulate_row(F.out + (size_t)m * D, F.g_mlp, F.modf + r * 6144 + 3072, F.modf + r * 6144 + 4096, F.H2 + (size_t)m * D, F.lane); }
}

__device__ __forceinline__ int keyrow_of(int m) { return (m < ML) ? ((m >> 12) * NKEY + NCTX + (m & 4095)) : (((m - ML) >> 8) * NKEY + ((m - ML) & 255)); }

__device__ __forceinline__ void phase3(Frame& F) {
    const int lane = F.lane;
    for (int m = F.gw; m < MA; m += F.ngw) {
        const bf16_t* Zr = F.Z + (size_t)m * INWP; const bool lat = m < ML; const int s = m & 4095; const int kr = keyrow_of(m);
        { const v2u w = *(const v2u*)(Zr + Z_CQ + 4 * lane); const float c0 = bflo(w.x), c1 = bfhi(w.x), c2 = bflo(w.y), c3 = bfhi(w.y);
          const float ss = wave_sum(c0 * c0 + c1 * c1 + c2 * c2 + c3 * c3); const float r = 1.0f / sqrtf(ss * (1.f / 256) + EPS);
          if (lat) { const f32x4 g = *(const f32x4*)(F.g_q_a + 4 * lane); v2u o; o.x = pk2(c0 * r * g.x, c1 * r * g.y); o.y = pk2(c2 * r * g.z, c3 * r * g.w); *(v2u*)(F.A1q + (size_t)m * 256 + 4 * lane) = o; } }
        { const unsigned w = *(const unsigned*)(Zr + Z_CKV + 2 * lane); const float c0 = bflo(w), c1 = bfhi(w);
          const float ss = wave_sum(c0 * c0 + c1 * c1); const float r = 1.0f / sqrtf(ss * (1.f / 128) + EPS);
          *(unsigned*)(F.A1kv + (size_t)m * 128 + 2 * lane) = pk2(c0 * r * F.g_kv_a[2 * lane], c1 * r * F.g_kv_a[2 * lane + 1]); }
        const int i32 = lane & 31;
        const float cs = lat ? F.cosS[s * 32 + i32] : 1.f, sn = lat ? F.sinS[s * 32 + i32] : 0.f;
        if (lat) {
            const float g = F.g_swa_q[lane];
#pragma unroll
            for (int h = 0; h < SH; ++h) { const float v = bf2f(Zr[Z_QS + h * 64 + lane]); const float ss = wave_sum(v * v); const float y = v * (1.0f / sqrtf(ss * (1.f / 64) + EPS)) * g;
                const float p = __shfl_xor(y, 32); const float o = (lane < 32) ? (y * cs - p * sn) : (y * cs + p * sn);
                F.QS[(size_t)m * 512 + h * 64 + lane] = (bf16_t)f2bf(o * SWA_C); }
        }
        { const float g = F.g_swa_k[lane];
#pragma unroll
          for (int h = 0; h < SKV; ++h) { const float v = bf2f(Zr[Z_KS + h * 64 + lane]); const float ss = wave_sum(v * v); const float y = v * (1.0f / sqrtf(ss * (1.f / 64) + EPS)) * g;
              const float p = __shfl_xor(y, 32); const float o = (lane < 32) ? (y * cs - p * sn) : (y * cs + p * sn);
              F.KS[(size_t)kr * 128 + h * 64 + lane] = (bf16_t)f2bf(o); }
          *(unsigned*)(F.VS + (size_t)kr * 128 + 2 * lane) = *(const unsigned*)(Zr + Z_VS + 2 * lane); }
    }
}

__device__ __forceinline__ void phase5(Frame& F) {
    const int lane = F.lane;
    for (int m = F.gw; m < MA; m += F.ngw) {
        const bool lat = m < ML; const int s = m & 4095; const int kr = keyrow_of(m);
        const int i16 = lane & 15;
        const float cs = lat ? F.cosM[s * 16 + i16] : 1.f, sn = lat ? F.sinM[s * 16 + i16] : 0.f;
        if (lat) {
            const float g0 = F.g_mla_q[lane], g1 = (lane < 32) ? F.g_mla_q[64 + lane] : 0.f;
#pragma unroll
            for (int h = 0; h < MH; ++h) { const bf16_t* q = F.QMraw + (size_t)m * 768 + h * 96;
                const float v0 = bf2f(q[lane]), v1 = (lane < 32) ? bf2f(q[64 + lane]) : 0.f;
                const float ss = wave_sum(v0 * v0 + v1 * v1); const float r = 1.0f / sqrtf(ss * (1.f / 96) + EPS);
                const float y0 = v0 * r * g0, y1 = v1 * r * g1; const float p = __shfl_xor(y1, 16);
                const float o1 = (lane < 16) ? (y1 * cs - p * sn) : (y1 * cs + p * sn);
                bf16_t* qo = F.QM + (size_t)m * 768 + h * 96; qo[lane] = (bf16_t)f2bf(y0 * MLA_C); if (lane < 32) qo[64 + lane] = (bf16_t)f2bf(o1 * MLA_C); }
        }
        { const float g0 = F.g_mla_k[lane], g1 = (lane < 32) ? F.g_mla_k[64 + lane] : 0.f;
          const float v1 = (lane < 32) ? bf2f(F.Z[(size_t)m * INWP + Z_KR + lane]) : 0.f;
#pragma unroll
          for (int h = 0; h < MH; ++h) { const bf16_t* kv = F.KVraw + (size_t)m * 1024 + h * 128;
              const float v0 = bf2f(kv[lane]);
              const float ss = wave_sum(v0 * v0 + v1 * v1); const float r = 1.0f / sqrtf(ss * (1.f / 96) + EPS);
              const float y0 = v0 * r * g0, y1 = v1 * r * g1; const float p = __shfl_xor(y1, 16);
              const float o1 = (lane < 16) ? (y1 * cs - p * sn) : (y1 * cs + p * sn);
              bf16_t* ko = F.KM + (size_t)kr * 768 + h * 96; ko[lane] = (bf16_t)f2bf(y0); if (lane < 32) ko[64 + lane] = (bf16_t)f2bf(o1);
              F.VM[(size_t)kr * 512 + h * 64 + lane] = kv[64 + lane]; } }
    }
}

__device__ __forceinline__ void phase6_mla(Frame& F) {
    const int lane = F.lane;
    for (int it = F.gw; it < NB * MH * (SEQ / 64); it += F.ngw) {
        const int b = it / (MH * 64), h = (it / 64) % MH, qc = it % 64; const int m = b * SEQ + qc * 64 + lane;
        float q[96];
        { const v4u* qp = (const v4u*)(F.QM + (size_t)m * 768 + h * 96);
#pragma unroll
          for (int c = 0; c < 12; ++c) { const v4u w = qp[c]; q[8 * c + 0] = bflo(w.x); q[8 * c + 1] = bfhi(w.x); q[8 * c + 2] = bflo(w.y); q[8 * c + 3] = bfhi(w.y); q[8 * c + 4] = bflo(w.z); q[8 * c + 5] = bfhi(w.z); q[8 * c + 6] = bflo(w.w); q[8 * c + 7] = bfhi(w.w); } }
        float o[64];
#pragma unroll
        for (int d = 0; d < 64; ++d) o[d] = 0.f;
        float mrun = -1e30f, l = 0.f;
        const bf16_t* Kb = F.KM + (size_t)b * NKEY * 768 + h * 96; const bf16_t* Vb = F.VM + (size_t)b * NKEY * 512 + h * 64;
#pragma unroll 1
        for (int j = 0; j < NKEY; ++j) {
            const v4u* kp = (const v4u*)(Kb + (size_t)j * 768); float a = 0.f;
#pragma unroll
            for (int c = 0; c < 12; ++c) { const v4u w = kp[c]; a += q[8 * c + 0] * bflo(w.x) + q[8 * c + 1] * bfhi(w.x) + q[8 * c + 2] * bflo(w.y) + q[8 * c + 3] * bfhi(w.y) + q[8 * c + 4] * bflo(w.z) + q[8 * c + 5] * bfhi(w.z) + q[8 * c + 6] * bflo(w.w) + q[8 * c + 7] * bfhi(w.w); }
            const float mn = fmaxf(a, mrun); const float al = __builtin_amdgcn_exp2f(mrun - mn); const float p = __builtin_amdgcn_exp2f(a - mn); l = l * al + p;
            const v4u* vp = (const v4u*)(Vb + (size_t)j * 512);
#pragma unroll
            for (int c = 0; c < 8; ++c) { const v4u w = vp[c]; o[8 * c + 0] = o[8 * c + 0] * al + p * bflo(w.x); o[8 * c + 1] = o[8 * c + 1] * al + p * bfhi(w.x); o[8 * c + 2] = o[8 * c + 2] * al + p * bflo(w.y); o[8 * c + 3] = o[8 * c + 3] * al + p * bfhi(w.y);
                o[8 * c + 4] = o[8 * c + 4] * al + p * bflo(w.z); o[8 * c + 5] = o[8 * c + 5] * al + p * bfhi(w.z); o[8 * c + 6] = o[8 * c + 6] * al + p * bflo(w.w); o[8 * c + 7] = o[8 * c + 7] * al + p * bfhi(w.w); }
            mrun = mn;
        }
        const float il = 1.0f / l; v4u* op = (v4u*)(F.MIX + (size_t)m * 1024 + h * 64);
#pragma unroll
        for (int c = 0; c < 8; ++c) { v4u w; w.x = pk2(o[8 * c] * il, o[8 * c + 1] * il); w.y = pk2(o[8 * c + 2] * il, o[8 * c + 3] * il); w.z = pk2(o[8 * c + 4] * il, o[8 * c + 5] * il); w.w = pk2(o[8 * c + 6] * il, o[8 * c + 7] * il); op[c] = w; }
    }
}
__device__ __forceinline__ void phase6_swa(Frame& F) {
    const int lane = F.lane;
    for (int it = F.gw; it < NB * SH * (SEQ / 64); it += F.ngw) {
        const int b = it / (SH * 64), h = (it / 64) % SH, qc = it % 64; const int q0 = qc * 64, qi = q0 + lane; const int m = b * SEQ + qi; const int kvh = h >> 2;
        float q[64];
        { const v4u* qp = (const v4u*)(F.QS + (size_t)m * 512 + h * 64);
#pragma unroll
          for (int c = 0; c < 8; ++c) { const v4u w = qp[c]; q[8 * c + 0] = bflo(w.x); q[8 * c + 1] = bfhi(w.x); q[8 * c + 2] = bflo(w.y); q[8 * c + 3] = bfhi(w.y); q[8 * c + 4] = bflo(w.z); q[8 * c + 5] = bfhi(w.z); q[8 * c + 6] = bflo(w.w); q[8 * c + 7] = bfhi(w.w); } }
        float o[64];
#pragma unroll
        for (int d = 0; d < 64; ++d) o[d] = 0.f;
        float mrun = -1e30f, l = 0.f;
        const bf16_t* Kb = F.KS + (size_t)b * NKEY * 128 + kvh * 64; const bf16_t* Vb = F.VS + (size_t)b * NKEY * 128 + kvh * 64;
        const int lo = (q0 - 128 > 0) ? q0 - 128 : 0, hi = (q0 + 63 + 128 < SEQ - 1) ? q0 + 63 + 128 : SEQ - 1;
        const int nband = hi - lo + 1, ntot = NCTX + nband;
#pragma unroll 1
        for (int j = 0; j < ntot; ++j) {
            const int key = (j < NCTX) ? j : (NCTX + lo + (j - NCTX));
            const int kpos = (j < NCTX) ? qi : (lo + (j - NCTX));
            const int dlt = qi - kpos; const bool valid = (dlt <= 128) && (dlt >= -128);
            const v4u* kp = (const v4u*)(Kb + (size_t)key * 128); float a = 0.f;
#pragma unroll
            for (int c = 0; c < 8; ++c) { const v4u w = kp[c]; a += q[8 * c + 0] * bflo(w.x) + q[8 * c + 1] * bfhi(w.x) + q[8 * c + 2] * bflo(w.y) + q[8 * c + 3] * bfhi(w.y) + q[8 * c + 4] * bflo(w.z) + q[8 * c + 5] * bfhi(w.z) + q[8 * c + 6] * bflo(w.w) + q[8 * c + 7] * bfhi(w.w); }
            if (!valid) a = -1e30f;
            const float mn = fmaxf(a, mrun); const float al = __builtin_amdgcn_exp2f(mrun - mn); const float p = valid ? __builtin_amdgcn_exp2f(a - mn) : 0.f; l = l * al + p;
            const v4u* vp = (const v4u*)(Vb + (size_t)key * 128);
#pragma unroll
            for (int c = 0; c < 8; ++c) { const v4u w = vp[c]; o[8 * c + 0] = o[8 * c + 0] * al + p * bflo(w.x); o[8 * c + 1] = o[8 * c + 1] * al + p * bfhi(w.x); o[8 * c + 2] = o[8 * c + 2] * al + p * bflo(w.y); o[8 * c + 3] = o[8 * c + 3] * al + p * bfhi(w.y);
                o[8 * c + 4] = o[8 * c + 4] * al + p * bflo(w.z); o[8 * c + 5] = o[8 * c + 5] * al + p * bfhi(w.z); o[8 * c + 6] = o[8 * c + 6] * al + p * bflo(w.w); o[8 * c + 7] = o[8 * c + 7] * al + p * bfhi(w.w); }
            mrun = mn;
        }
        { const float a = F.swa_sink[h] * LOG2E; const float mn = fmaxf(a, mrun); const float al = __builtin_amdgcn_exp2f(mrun - mn); l = l * al + __builtin_amdgcn_exp2f(a - mn);
#pragma unroll
          for (int d = 0; d < 64; ++d) o[d] *= al; }
        const float il = 1.0f / l; v4u* op = (v4u*)(F.MIX + (size_t)m * 1024 + 512 + h * 64);
#pragma unroll
        for (int c = 0; c < 8; ++c) { v4u w; w.x = pk2(o[8 * c] * il, o[8 * c + 1] * il); w.y = pk2(o[8 * c + 2] * il, o[8 * c + 3] * il); w.z = pk2(o[8 * c + 4] * il, o[8 * c + 5] * il); w.w = pk2(o[8 * c + 6] * il, o[8 * c + 7] * il); op[c] = w; }
    }
}

constexpr int NPHASE = 11;
__global__ void __launch_bounds__(NTHREADS, 2) fwd_kernel(Args args) {
    extern __shared__ __attribute__((aligned(16))) unsigned char lds_raw[];
    Frame F;
    F.lds = (LAS unsigned char*)lds_raw;
    F.tid = threadIdx.x; F.lane = F.tid & 63; F.wave = __builtin_amdgcn_readfirstlane(F.tid >> 6);
    F.G = gridDim.x; F.bid = blockIdx.x; F.gw = F.bid * NWAVES + F.wave; F.ngw = F.G * NWAVES;
    unsigned char* ws = args.ws;
    F.x = args.in[0]; F.c = args.in[1]; F.ctx = args.in[2]; F.c_ctx = args.in[3]; F.w_mod = args.in[4]; F.b_mod = args.in[5]; F.g_attn = args.in[6]; F.w_in = args.in[7];
    F.g_q_a = args.in[8]; F.w_uq = args.in[9]; F.g_kv_a = args.in[10]; F.w_ukv = args.in[11]; F.g_mla_q = args.in[12]; F.g_mla_k = args.in[13]; F.g_swa_q = args.in[14]; F.g_swa_k = args.in[15];
    F.swa_sink = args.in[16]; F.w_out = args.in[17]; F.g_mlp = args.in[18]; F.w_mlp1 = args.in[19]; F.w_mlp2 = args.in[20]; F.out = args.out;
    F.modf = (float*)(ws + WS_MODF); F.cosS = (float*)(ws + WS_ROPE); F.sinS = F.cosS + SEQ * 32; F.cosM = F.sinS + SEQ * 32; F.sinM = F.cosM + SEQ * 16;
    F.Win_t = (bf16_t*)(ws + WS_WIN); F.Wuq_t = (bf16_t*)(ws + WS_WUQ); F.Wukv_t = (bf16_t*)(ws + WS_WUKV); F.Wout_t = (bf16_t*)(ws + WS_WOUT); F.W1_t = (bf16_t*)(ws + WS_W1); F.W2_t = (bf16_t*)(ws + WS_W2);
    F.H = (bf16_t*)(ws + WS_H); F.Z = (bf16_t*)(ws + WS_Z); F.A1q = (bf16_t*)(ws + WS_A1Q); F.A1kv = (bf16_t*)(ws + WS_A1KV); F.QMraw = (bf16_t*)(ws + WS_H); F.KVraw = (bf16_t*)(ws + WS_KVRAW);
    F.QM = (bf16_t*)(ws + WS_QM); F.KM = (bf16_t*)(ws + WS_KM); F.VM = (bf16_t*)(ws + WS_VM); F.QS = (bf16_t*)(ws + WS_QS); F.KS = (bf16_t*)(ws + WS_KS); F.VS = (bf16_t*)(ws + WS_VS);
    F.MIX = (bf16_t*)(ws + WS_KVRAW); F.H2 = (bf16_t*)(ws + WS_H); F.ACT = (bf16_t*)(ws + WS_ACT);
    volatile LAS unsigned* MISC = (volatile LAS unsigned*)(F.lds + MISC_OFF);
    for (int u = F.tid; u < 64; u += NTHREADS) MISC[u] = 0u;
    __syncthreads();
    unsigned* ctl = (unsigned*)(ws + WS_CTL);
    XcdBarrier bar; bar.bar = ctl + CW_BAR; bar.x = 0; bar.st = nullptr;
    if (MK_N_LAUNCHES == 1) bar = xcd_barrier_post(ctl + CW_BAR, MISC + 8);
    const int lo = args.ph_lo, hi = args.ph_hi;
#define IN(k) (lo <= (k) && (k) < hi)
#define SEAM(k) do { if (IN(k) && IN((k) + 1)) xcd_barrier(bar); } while (0)
    if (IN(0)) { phase0(F); } SEAM(0);
    if (IN(1)) { phase1(F); } SEAM(1);
    if (IN(2)) { EpiStoreBf16 E{F.Z, INWP, INW}; sgemm_phase(F.H, D, F.Win_t, D, MA, INW, D, F.gw, F.ngw, F.lane, E); } SEAM(2);
    if (IN(3)) { phase3(F); } SEAM(3);
    if (IN(4)) { EpiStoreBf16 E1{F.QMraw, 768, 768}; sgemm_phase(F.A1q, QLORA, F.Wuq_t, QLORA, ML, 768, QLORA, F.gw, F.ngw, F.lane, E1);
                 EpiStoreBf16 E2{F.KVraw, 1024, 1024}; sgemm_phase(F.A1kv, KVLORA, F.Wukv_t, KVLORA, MA, 1024, KVLORA, F.gw, F.ngw, F.lane, E2); } SEAM(4);
    if (IN(5)) { phase5(F); } SEAM(5);
    if (IN(6)) { phase6_mla(F); phase6_swa(F); } SEAM(6);
    if (IN(7)) { EpiGateRes E{F.x, F.out, F.modf + 2048}; sgemm_phase(F.MIX, D, F.Wout_t, D, ML, D, D, F.gw, F.ngw, F.lane, E); } SEAM(7);
    if (IN(8)) { phase8(F); } SEAM(8);
    if (IN(9)) { EpiRelu2 E{F.ACT, FF}; sgemm_phase(F.H2, D, F.W1_t, D, ML, FF, D, F.gw, F.ngw, F.lane, E); } SEAM(9);
    if (IN(10)) { EpiGateRes E{F.out, F.out, F.modf + 5120}; sgemm_phase(F.ACT, FF, F.W2_t, FF, ML, D, FF, F.gw, F.ngw, F.lane, E); }
#undef IN
#undef SEAM
}

extern "C" void kernel_launch(void* const* d_in, const int* in_sizes, int n_in, void* d_out, int out_size, void* d_ws, size_t ws_size, hipStream_t stream) {
    static int grid = 0;
    if (grid == 0) {
        if (n_in != 21 || out_size != ML * D || ws_size < WS_END) { fprintf(stderr, "kernel_launch: unexpected problem shape (n_in %d, out %d, ws %zu)\n", n_in, out_size, ws_size); grid = -1; return; }
        int dev = 0, cus = 0, per_cu = 0;
        if (hipGetDevice(&dev) != hipSuccess || hipDeviceGetAttribute(&cus, hipDeviceAttributeMultiprocessorCount, dev) != hipSuccess) { grid = -1; return; }
        if (hipFuncSetAttribute((const void*)fwd_kernel, hipFuncAttributeMaxDynamicSharedMemorySize, LDS_BYTES) != hipSuccess) { fprintf(stderr, "kernel_launch: hipFuncSetAttribute failed\n"); grid = -1; return; }
        if (hipOccupancyMaxActiveBlocksPerMultiprocessor(&per_cu, (const void*)fwd_kernel, NTHREADS, LDS_BYTES) != hipSuccess || per_cu < 1) { fprintf(stderr, "kernel_launch: occupancy query says %d\n", per_cu); }
        (void)hipGetLastError();
        grid = cus;
    }
    if (grid < 0) return;
    (void)hipMemsetAsync((char*)d_ws + WS_CTL, 0, CTL_ZERO_BYTES, stream);
    Args a{};
    for (int i = 0; i < 21; ++i) a.in[i] = (const float*)d_in[i];
    a.out = (float*)d_out; a.ws = (unsigned char*)d_ws;
    if (MK_N_LAUNCHES == 1) { a.ph_lo = 0; a.ph_hi = NPHASE; hipLaunchKernelGGL(fwd_kernel, dim3(grid), dim3(NTHREADS), LDS_BYTES, stream, a); }
    else { for (int p = 0; p < NPHASE; ++p) { a.ph_lo = p; a.ph_hi = p + 1; hipLaunchKernelGGL(fwd_kernel, dim3(grid), dim3(NTHREADS), LDS_BYTES, stream, a); } }
}
```

```cpp
#include <hip/hip_runtime.h>
#include <cstdio>
#include <cstdint>

#ifndef MK_N_LAUNCHES
#define MK_N_LAUNCHES 1
#endif

constexpr int D = 1024, NB = 4, SEQ = 4096, NCTX = 256, GRIDW = 64;
constexpr int ML = NB * SEQ;
constexpr int MC = NB * NCTX;
constexpr int MA = ML + MC;
constexpr int NKEY = NCTX + SEQ;
constexpr int INW = 1184, INWP = 1280;
constexpr int QLORA = 256, KVLORA = 128;
constexpr int MH = 8, MQK = 96, MNOPE = 64, MROPE = 32, MV = 64;
constexpr int SH = 8, SKV = 2, SHD = 64;
constexpr int FF = 4096;
constexpr int Z_CQ = 0, Z_CKV = 256, Z_KR = 384, Z_QS = 416, Z_KS = 928, Z_VS = 1056;
constexpr float EPS = 1e-6f;
constexpr float LOG2E = 1.4426950408889634f;
constexpr float MLA_C = 0.10206207261596577f * LOG2E;
constexpr float SWA_C = 0.125f * LOG2E;
constexpr int NWAVES = 8, NTHREADS = 512;

constexpr size_t MiB = 1u << 20;
constexpr size_t WS_CTL = 0, CTL_ZERO_BYTES = 1 * MiB;
constexpr size_t WS_MODF = 1 * MiB;
constexpr size_t WS_ROPE = 1 * MiB + 256 * 1024;
constexpr size_t WS_WIN = 3 * MiB;
constexpr size_t WS_WUQ = 6 * MiB;
constexpr size_t WS_WUKV = 7 * MiB;
constexpr size_t WS_WOUT = 8 * MiB;
constexpr size_t WS_W1 = 10 * MiB;
constexpr size_t WS_W2 = 18 * MiB;
constexpr size_t WS_H = 26 * MiB;
constexpr size_t WS_Z = 60 * MiB;
constexpr size_t WS_A1Q = 103 * MiB;
constexpr size_t WS_A1KV = 111 * MiB;
constexpr size_t WS_QM = 116 * MiB;
constexpr size_t WS_KM = 140 * MiB;
constexpr size_t WS_VM = 166 * MiB;
constexpr size_t WS_QS = 183 * MiB;
constexpr size_t WS_KS = 199 * MiB;
constexpr size_t WS_VS = 204 * MiB;
constexpr size_t WS_KVRAW = 209 * MiB;
constexpr size_t WS_ACT = 60 * MiB;
constexpr size_t WS_END = 256 * MiB;
static_assert(WS_KVRAW + (size_t)MA * 1024 * 2 <= WS_END && WS_ACT + (size_t)ML * FF * 2 <= WS_KVRAW, "ws map");

constexpr int CW_BAR = 4096;

constexpr int LDS_BYTES = 147456;
constexpr int MISC_OFF = 131072 + 320;

#define GAS __attribute__((address_space(1)))
#define LAS __attribute__((address_space(3)))
typedef unsigned short bf16_t;
typedef unsigned v4u __attribute__((ext_vector_type(4)));
typedef unsigned v2u __attribute__((ext_vector_type(2)));
typedef float f32x4 __attribute__((ext_vector_type(4)));
typedef short bf16x8 __attribute__((ext_vector_type(8)));

__device__ __forceinline__ unsigned f2bf(float f) { unsigned u = __builtin_bit_cast(unsigned, f); return (u + 0x7fffu + ((u >> 16) & 1u)) >> 16; }
__device__ __forceinline__ unsigned pk2(float lo, float hi) { return f2bf(lo) | (f2bf(hi) << 16); }
__device__ __forceinline__ float bflo(unsigned w) { return __builtin_bit_cast(float, w << 16); }
__device__ __forceinline__ float bfhi(unsigned w) { return __builtin_bit_cast(float, w & 0xffff0000u); }
__device__ __forceinline__ float bf2f(bf16_t h) { return __builtin_bit_cast(float, (unsigned)h << 16); }
__device__ __forceinline__ float wave_sum(float v) {
#pragma unroll
    for (int o = 1; o < 64; o <<= 1) v += __shfl_xor(v, o);
    return v;
}

__device__ __forceinline__ int opq(int i) { asm volatile("" : "+s"(i)); return i; }

#define XB_TMO      128
#define XB_XCNT(j)  (256  + 64 * (j))
#define XB_XSUB(j)  (1280 + 64 * (j))
#define XB_XGEN(j)  (2304 + 64 * (j))
#define XB_TOP      3328
#define XB_TOPGEN   3392
#define XCD_BAR_WORDS 3456
#define XB_SPIN_CAP (1u << 18)
__device__ __forceinline__ unsigned xb_ld(unsigned* p)              { return __hip_atomic_load(p, __ATOMIC_RELAXED, __HIP_MEMORY_SCOPE_AGENT); }
__device__ __forceinline__ unsigned xb_add(unsigned* p, unsigned v) { return __hip_atomic_fetch_add(p, v, __ATOMIC_RELAXED, __HIP_MEMORY_SCOPE_AGENT); }
__device__ __forceinline__ unsigned xb_xcc_id() { return (unsigned)__builtin_amdgcn_s_getreg((3 << 11) | 20) & 0xFu; }
#define XB_SPIN(cond, bar) do { unsigned _sp = 0; while (cond) { __builtin_amdgcn_s_sleep(1); \
    if ((++_sp & 255u) == 0u) { if (xb_ld(&(bar)[XB_TMO])) break; if (_sp > XB_SPIN_CAP) { atomicAdd(&(bar)[XB_TMO], 1u); break; } } } } while (0)
struct XcdBarrier { unsigned* bar; unsigned x; volatile LAS unsigned* st; };
__device__ __forceinline__ XcdBarrier xcd_barrier_post(unsigned* bar, volatile LAS unsigned* st) {
    XcdBarrier b; b.bar = bar; b.x = xb_xcc_id(); b.st = st;
    if (threadIdx.x == 0) (void)xb_add(&bar[XB_XCNT(b.x)], 1u);
    return b;
}
__device__ __forceinline__ void xcd_barrier_complete(unsigned* bar, unsigned x, unsigned& nloc, unsigned& nx) {
    const unsigned G = gridDim.x * gridDim.y * gridDim.z;
    unsigned sum, cnt, mine, sp = 0u;
    for (;;) {
        sum = 0u; cnt = 0u; mine = 0u;
#pragma unroll
        for (unsigned j = 0; j < 16; ++j) { const unsigned c = xb_ld(&bar[XB_XCNT(j)]); sum += c; cnt += (c > 0u) ? 1u : 0u; mine = (j == x) ? c : mine; }
        if (sum == G) break;
        __builtin_amdgcn_s_sleep(1);
        if ((++sp & 255u) == 0u) { if (xb_ld(&bar[XB_TMO])) break; if (sp > XB_SPIN_CAP) { atomicAdd(&bar[XB_TMO], 1u); break; } }
    }
    nloc = mine > 0u ? mine : 1u; nx = cnt > 0u ? cnt : 1u;
}
__device__ __forceinline__ void xcd_barrier(const XcdBarrier& b) {
    asm volatile("s_waitcnt vmcnt(0)" ::: "memory");
    __syncthreads();
    if (threadIdx.x == 0) {
        unsigned* bar = b.bar;
        __builtin_amdgcn_s_waitcnt(0);
        unsigned nloc = b.st[0], nx = b.st[1];
        if (nloc == 0u) { xcd_barrier_complete(bar, b.x, nloc, nx); b.st[0] = nloc; b.st[1] = nx; }
        const unsigned old = xb_add(&bar[XB_XSUB(b.x)], 1u);
        const unsigned gen = old / nloc;
        if (old + 1u == (gen + 1u) * nloc) {
            __builtin_amdgcn_fence(__ATOMIC_RELEASE, "agent");
            asm volatile("s_waitcnt vmcnt(0)" ::: "memory");
            const unsigned og = xb_add(&bar[XB_TOP], 1u);
            const unsigned tg = og / nx;
            if (og + 1u == (tg + 1u) * nx) xb_add(&bar[XB_TOPGEN], 1u);
            else XB_SPIN(xb_ld(&bar[XB_TOPGEN]) == tg, bar);
            __builtin_amdgcn_fence(__ATOMIC_ACQUIRE, "agent");
            xb_add(&bar[XB_XGEN(b.x)], 1u);
            asm volatile("s_waitcnt vmcnt(0)" ::: "memory");
        } else {
            XB_SPIN(xb_ld(&bar[XB_XGEN(b.x)]) == gen, bar);
            __builtin_amdgcn_fence(__ATOMIC_ACQUIRE, "agent");
            asm volatile("s_waitcnt vmcnt(0)" ::: "memory");
        }
    }
    __syncthreads();
}

struct Args { const float* in[21]; float* out; unsigned char* ws; int ph_lo, ph_hi; };
struct Frame {
    LAS unsigned char* lds;
    int tid, lane, wave, G, bid, gw, ngw;
};

template <class Epi>
__device__ __forceinline__ void sgemm_phase(const bf16_t* A, int lda, const bf16_t* Bt, int ldb, int M, int N, int K, int gw, int ngw, int lane, const Epi& E) {
    const int tm = M / 64, tn = (N + 63) / 64, fr = lane & 15, fq = lane >> 4;
    for (int t = gw; t < tm * tn; t += ngw) {
        const int pm = t / tn, pn = t % tn;
        f32x4 acc[4][4];
#pragma unroll
        for (int i = 0; i < 4; ++i)
#pragma unroll
            for (int j = 0; j < 4; ++j) acc[i][j] = (f32x4){0.f, 0.f, 0.f, 0.f};
        const bf16_t* ap = A + (size_t)(pm * 64 + fr) * lda + 8 * fq;
        const bf16_t* bp = Bt + (size_t)(pn * 64 + fr) * ldb + 8 * fq;
        for (int k = 0; k < K; k += 32) {
            bf16x8 a[4], b[4];
#pragma unroll
            for (int i = 0; i < 4; ++i) a[i] = *(const bf16x8*)(ap + (size_t)i * 16 * lda + k);
#pragma unroll
            for (int j = 0; j < 4; ++j) b[j] = *(const bf16x8*)(bp + (size_t)j * 16 * ldb + k);
#pragma unroll
            for (int i = 0; i < 4; ++i)
#pragma unroll
                for (int j = 0; j < 4; ++j) acc[i][j] = __builtin_amdgcn_mfma_f32_16x16x32_bf16(b[j], a[i], acc[i][j], 0, 0, 0);
        }
#pragma unroll
        for (int i = 0; i < 4; ++i)
#pragma unroll
            for (int j = 0; j < 4; ++j) E(pm * 64 + i * 16 + fr, pn * 64 + j * 16 + 4 * fq, acc[i][j]);
    }
}
struct EpiStoreBf16 { bf16_t* O; int ldc; int ncols;
    __device__ __forceinline__ void operator()(int row, int col, f32x4 v) const { if (col < ncols) { v2u w; w.x = pk2(v[0], v[1]); w.y = pk2(v[2], v[3]); *(v2u*)(O + (size_t)row * ldc + col) = w; } } };
struct EpiRelu2 { bf16_t* O; int ldc;
    __device__ __forceinline__ void operator()(int row, int col, f32x4 v) const { f32x4 r; for (int i = 0; i < 4; ++i) { float t = v[i] > 0.f ? v[i] : 0.f; r[i] = t * t; } v2u w; w.x = pk2(r[0], r[1]); w.y = pk2(r[2], r[3]); *(v2u*)(O + (size_t)row * ldc + col) = w; } };
struct EpiGateRes { const float* base; float* out; const float* gate  ;
    __device__ __forceinline__ void operator()(int row, int col, f32x4 v) const { const int b = row >> 12; const f32x4 g = *(const f32x4*)(gate + (size_t)b * 6144 + col); const f32x4 x0 = *(const f32x4*)(base + (size_t)row * D + col);
        *(f32x4*)(out + (size_t)row * D + col) = x0 + g * v; } };


namespace pg8 {
#define PG8_LAS __attribute__((address_space(3)))
constexpr int BM = 256, BK = 64, HALF = 128, HTB = HALF * BK * 2, STAGE_BYTES = 8 * HTB, NXCD = 8, WGM = 8;
__host__ __device__ __forceinline__ int lds_byte(int r, int c) { const int st = (r >> 4) * 2 + (c >> 5), rr = r & 15, cc = c & 31, ob = rr * 64 + cc * 2; return st * 1024 + (ob ^ (((ob >> 9) & 1) << 5)); }
__host__ __device__ __forceinline__ void stage_rc(int b, int& R, int& C) { const int st = b / 1024, sb = b % 1024, swz = sb ^ (((sb >> 9) & 1) << 5); R = (st >> 1) * 16 + swz / 64; C = (st & 1) * 32 + (swz % 64) / 2; }
__host__ __device__ __forceinline__ int perm32(int rho) { const int n = rho >> 4, i = rho & 15; return 8 * (i >> 2) + 4 * n + (i & 3); }
struct Unit { int pm, pn; };
struct Gemm { const bf16_t* A; const bf16_t* Bt; int M, N, K; };
struct StaticOrder {
    int nM, nN, nwg, G, c;
    __host__ __device__ void init(int M, int N, int G_, int c_) { nM = M / BM; nN = N / BM; nwg = nM * nN; G = G_; c = c_; }
    __host__ __device__ bool next(int i, Unit& u) const {
        const long L = (long)i * G + c; if (L >= nwg) return false;
        int wgid = (int)L; { const int q = nwg / NXCD, r = nwg % NXCD, xcd = wgid % NXCD, off = wgid / NXCD; wgid = (xcd < r ? xcd * (q + 1) : r * (q + 1) + (xcd - r) * q) + off; }
        const int nig = WGM * nN, gid = wgid / nig, fm = gid * WGM, gsz = (nM - fm) < WGM ? (nM - fm) : WGM;
        u.pm = fm + ((wgid % nig) % gsz); u.pn = (wgid % nig) / gsz; return true;
    }
    __device__ __forceinline__ void a_ready(const Unit&) const {}
    __device__ __forceinline__ void done(const Unit&) const {}
};
typedef float f32x2_t __attribute__((ext_vector_type(2))); typedef __bf16 bf16x2_t __attribute__((ext_vector_type(2)));
__device__ __forceinline__ unsigned cvtpk(float lo, float hi) { f32x2_t v = {lo, hi}; bf16x2_t b = __builtin_convertvector(v, bf16x2_t); return __builtin_bit_cast(unsigned, b); }
template <int ACT  > struct EpiBf16 {
    static constexpr bool PERM = true, AFTER_DRAIN = false;
    bf16_t* O; int ldc;
    __device__ __forceinline__ void operator()(const f32x4 (&acc)[2][2][4][2], const Unit& u, int wr, int wc, int fr, int fq) const {
        const int row0 = u.pm * BM + wr * 64 + fr, col0 = u.pn * BM + wc * 32 + 8 * fq;
#pragma unroll
        for (int ai = 0; ai < 2; ++ai)
#pragma unroll
            for (int m = 0; m < 4; ++m) { bf16_t* rowp = O + (size_t)(row0 + ai * HALF + m * 16) * ldc + col0;
#pragma unroll
                for (int bj = 0; bj < 2; ++bj) { f32x4 v0 = acc[ai][bj][m][0], v1 = acc[ai][bj][m][1];
                    if (ACT == 1) {
#pragma unroll
                        for (int i = 0; i < 4; ++i) { const float a = v0[i] > 0.f ? v0[i] : 0.f, b = v1[i] > 0.f ? v1[i] : 0.f; v0[i] = a * a; v1[i] = b * b; } }
                    v4u w; w.x = cvtpk(v0[0], v0[1]); w.y = cvtpk(v0[2], v0[3]); w.z = cvtpk(v1[0], v1[1]); w.w = cvtpk(v1[2], v1[3]);
                    *(v4u*)(rowp + bj * HALF) = w; } }
    }
};
struct EpiGate {
    static constexpr bool PERM = false, AFTER_DRAIN = false;
    const float* base; float* out; const float* gate;
    __device__ __forceinline__ void operator()(const f32x4 (&acc)[2][2][4][2], const Unit& u, int wr, int wc, int fr, int fq) const {
        const int b = (u.pm * BM) >> 12; const int col0 = u.pn * BM + wc * 32 + 4 * fq;
        f32x4 g[2][2];
#pragma unroll
        for (int bj = 0; bj < 2; ++bj)
#pragma unroll
            for (int n = 0; n < 2; ++n) g[bj][n] = *(const f32x4*)(gate + (size_t)b * 6144 + col0 + bj * HALF + n * 16);
#pragma unroll
        for (int ai = 0; ai < 2; ++ai)
#pragma unroll
            for (int m = 0; m < 4; ++m) { const size_t off = (size_t)(u.pm * BM + ai * HALF + wr * 64 + m * 16 + fr) * D + col0;
#pragma unroll
                for (int bj = 0; bj < 2; ++bj)
#pragma unroll
                    for (int n = 0; n < 2; ++n) { const f32x4 bs = *(const f32x4*)(base + off + bj * HALF + n * 16); *(f32x4*)(out + off + bj * HALF + n * 16) = bs + g[bj][n] * acc[ai][bj][m][n]; } }
    }
};
template <class Epi, class Sched, bool ALIGN_EPI = false, bool SP2 = false>
__device__ __forceinline__ void gemm_phase(PG8_LAS unsigned char* lds, const Gemm g, const Sched& S, const Epi& E) {
    const int tid = threadIdx.x, wid = __builtin_amdgcn_readfirstlane(tid >> 6), lane = tid & 63, wr = wid >> 2, wc = wid & 3, fr = lane & 15, fq = lane >> 4;
    const int K = g.K, nt = K / BK;
    unsigned voffA[2], voffB[2];
#pragma unroll
    for (int i = 0; i < 2; ++i) { int R, C; stage_rc(tid * 16 + i * 8192, R, C); const int Rb = Epi::PERM ? ((R & ~31) + perm32(R & 31)) : R;
        voffA[i] = (unsigned)(R * K + C) * 2u; voffB[i] = (unsigned)(Rb * K + C) * 2u; }
    const size_t kstep = (size_t)(BK * 2);
    const size_t hstep = (size_t)HALF * K * 2;
    const size_t tstep = 2 * hstep;
    const unsigned ldsw = (unsigned)wid * 1024u;
    const int aoff = lds_byte(wr * 64 + fr, fq * 8), boff = lds_byte(wc * 32 + fr, fq * 8);
#define PG8_SA(b, h) (((b) * 2 + (h)) * HTB)
#define PG8_SB(b, h) ((4 + (b) * 2 + (h)) * HTB)
#define PG8_STAGE(bufoff, gbase, voff) do { _Pragma("unroll") for (int _i = 0; _i < 2; ++_i) \
        __builtin_amdgcn_global_load_lds((const unsigned*)((const char*)(gbase) + (voff)[_i]), (PG8_LAS unsigned*)(lds + (bufoff) + ldsw + _i * 8192), 16, 0, 0); } while (0)
#define PG8_LDA(dst, b, h) do { _Pragma("unroll") for (int m = 0; m < 4; ++m) _Pragma("unroll") for (int k = 0; k < 2; ++k) dst[m][k] = *(const PG8_LAS bf16x8*)(lds + PG8_SA(b, h) + aoff + m * 2048 + k * 1024); } while (0)
#define PG8_LDB(dst, b, h) do { _Pragma("unroll") for (int n = 0; n < 2; ++n) _Pragma("unroll") for (int k = 0; k < 2; ++k) dst[n][k] = *(const PG8_LAS bf16x8*)(lds + PG8_SB(b, h) + boff + n * 2048 + k * 1024); } while (0)
#define PG8_MMA(ai, bj, At, Bt) do { __builtin_amdgcn_s_setprio(1); _Pragma("unroll") for (int m = 0; m < 4; ++m) _Pragma("unroll") for (int n = 0; n < 2; ++n) _Pragma("unroll") for (int k = 0; k < 2; ++k) \
        acc[ai][bj][m][n] = __builtin_amdgcn_mfma_f32_16x16x32_bf16(Bt[n][k], At[m][k], acc[ai][bj][m][n], 0, 0, 0); __builtin_amdgcn_s_setprio(0); } while (0)
#define PG8_WAIT_V(n) asm volatile("s_waitcnt vmcnt(" #n ")" ::: "memory")
#define PG8_WAIT_L(n) asm volatile("s_waitcnt lgkmcnt(" #n ")" ::: "memory")
#define PG8_BAR __builtin_amdgcn_s_barrier()
#define PG8_SCHED __builtin_amdgcn_sched_barrier(0)
    Unit cur, nxt; int ui = 0;
    if (!S.next(0, cur)) return;
    f32x4 acc[2][2][4][2];
#pragma unroll
    for (int a = 0; a < 2; ++a)
#pragma unroll
        for (int b = 0; b < 2; ++b)
#pragma unroll
            for (int m = 0; m < 4; ++m)
#pragma unroll
                for (int n = 0; n < 2; ++n) acc[a][b][m][n] = (f32x4){0.f, 0.f, 0.f, 0.f};
    bf16x8 At[4][2], B0[2][2], B1[2][2];
    const char* cA = (const char*)g.A + (size_t)cur.pm * tstep; const char* cB = (const char*)g.Bt + (size_t)cur.pn * tstep;
    S.a_ready(cur);
    if constexpr (SP2) {
        PG8_STAGE(PG8_SB(0, 0), cB, voffB); PG8_STAGE(PG8_SB(0, 1), cB + hstep, voffB); PG8_STAGE(PG8_SA(0, 0), cA, voffA); PG8_STAGE(PG8_SA(0, 1), cA + hstep, voffA);
        if (wr == 1) PG8_BAR;
        PG8_WAIT_V(2); PG8_BAR;
        PG8_STAGE(PG8_SB(1, 0), cB + kstep, voffB); PG8_STAGE(PG8_SA(1, 0), cA + kstep, voffA); PG8_STAGE(PG8_SB(1, 1), cB + hstep + kstep, voffB);
        PG8_WAIT_V(6); PG8_BAR;
    } else {
        PG8_STAGE(PG8_SB(0, 0), cB, voffB); PG8_STAGE(PG8_SA(0, 0), cA, voffA); PG8_STAGE(PG8_SB(0, 1), cB + hstep, voffB); PG8_STAGE(PG8_SA(0, 1), cA + hstep, voffA);
        if (wr == 1) PG8_BAR;
        PG8_WAIT_V(4); PG8_BAR;
        PG8_STAGE(PG8_SB(1, 0), cB + kstep, voffB); PG8_STAGE(PG8_SA(1, 0), cA + kstep, voffA); PG8_STAGE(PG8_SB(1, 1), cB + hstep + kstep, voffB);
        PG8_WAIT_V(6); PG8_BAR;
    }
    for (;;) {
        const bool has_next = S.next(ui + 1, nxt);
        const char* nA = has_next ? (const char*)g.A + (size_t)nxt.pm * tstep : cA; const char* nB = has_next ? (const char*)g.Bt + (size_t)nxt.pn * tstep : cB;
        for (int t = 0; t < nt; t += 2) {
            const bool last = (t == nt - 2);
            const char* a1 = cA + (size_t)(t + 1) * kstep;
            const char* a2 = last ? nA : cA + (size_t)(t + 2) * kstep; const char* b2 = last ? nB : cB + (size_t)(t + 2) * kstep;
            const char* a3 = a2 + kstep; const char* b3 = b2 + kstep;
            if (last && has_next) S.a_ready(nxt);
            if constexpr (SP2) {
            PG8_LDB(B0, 0, 0); PG8_LDB(B1, 0, 1); PG8_SCHED; PG8_LDA(At, 0, 0); PG8_STAGE(PG8_SA(1, 1), a1 + hstep, voffA);
            PG8_WAIT_V(8); PG8_WAIT_L(0); PG8_BAR; PG8_MMA(0, 0, At, B0); PG8_MMA(0, 1, At, B1); PG8_BAR; PG8_SCHED;
            PG8_LDA(At, 0, 1); PG8_STAGE(PG8_SB(0, 0), b2, voffB); PG8_STAGE(PG8_SB(0, 1), b2 + hstep, voffB); PG8_STAGE(PG8_SA(0, 0), a2, voffA);
            PG8_WAIT_V(8); PG8_WAIT_L(0); PG8_BAR; PG8_MMA(1, 0, At, B0); PG8_MMA(1, 1, At, B1); PG8_BAR; PG8_SCHED;
            PG8_LDB(B0, 1, 0); PG8_LDB(B1, 1, 1); PG8_SCHED; PG8_LDA(At, 1, 0); PG8_STAGE(PG8_SA(0, 1), a2 + hstep, voffA);
            PG8_WAIT_V(8); PG8_WAIT_L(0); PG8_BAR; PG8_MMA(0, 0, At, B0); PG8_MMA(0, 1, At, B1); PG8_BAR; PG8_SCHED;
            PG8_LDA(At, 1, 1); PG8_STAGE(PG8_SB(1, 0), b3, voffB); PG8_STAGE(PG8_SB(1, 1), b3 + hstep, voffB); PG8_STAGE(PG8_SA(1, 0), a3, voffA);
            PG8_WAIT_V(8); PG8_WAIT_L(0); PG8_BAR; PG8_MMA(1, 0, At, B0); PG8_MMA(1, 1, At, B1); PG8_BAR; PG8_SCHED;
            } else {
            PG8_LDB(B0, 0, 0); PG8_SCHED; PG8_LDA(At, 0, 0); PG8_STAGE(PG8_SA(1, 1), a1 + hstep, voffA);
            PG8_WAIT_L(8); PG8_BAR; PG8_WAIT_L(0); PG8_MMA(0, 0, At, B0); PG8_BAR; PG8_SCHED;
            PG8_LDB(B1, 0, 1); PG8_STAGE(PG8_SB(0, 0), b2, voffB);
            PG8_BAR; PG8_WAIT_L(0); PG8_MMA(0, 1, At, B1); PG8_BAR;
            PG8_LDA(At, 0, 1); PG8_STAGE(PG8_SA(0, 0), a2, voffA);
            PG8_BAR; PG8_WAIT_L(0); PG8_MMA(1, 0, At, B0); PG8_BAR; PG8_SCHED;
            PG8_STAGE(PG8_SB(0, 1), b2 + hstep, voffB);
            PG8_WAIT_V(6); PG8_BAR; PG8_MMA(1, 1, At, B1); PG8_BAR;
            PG8_LDB(B0, 1, 0); PG8_SCHED; PG8_LDA(At, 1, 0); PG8_STAGE(PG8_SA(0, 1), a2 + hstep, voffA);
            PG8_WAIT_L(8); PG8_BAR; PG8_WAIT_L(0); PG8_MMA(0, 0, At, B0); PG8_BAR; PG8_SCHED;
            PG8_LDB(B1, 1, 1); PG8_STAGE(PG8_SB(1, 0), b3, voffB);
            PG8_BAR; PG8_WAIT_L(0); PG8_MMA(0, 1, At, B1); PG8_BAR;
            PG8_LDA(At, 1, 1); PG8_STAGE(PG8_SA(1, 0), a3, voffA);
            PG8_BAR; PG8_WAIT_L(0); PG8_MMA(1, 0, At, B0); PG8_BAR; PG8_SCHED;
            PG8_STAGE(PG8_SB(1, 1), b3 + hstep, voffB);
            PG8_WAIT_V(6); PG8_BAR; PG8_MMA(1, 1, At, B1); PG8_BAR;
            }
        }
        if constexpr (ALIGN_EPI) { if (wr == 0) PG8_BAR; }
        if constexpr (!Epi::AFTER_DRAIN) { E(acc, cur, wr, wc, fr, fq); S.done(cur); }
        if (!has_next) break;
#pragma unroll
        for (int a = 0; a < 2; ++a)
#pragma unroll
            for (int b = 0; b < 2; ++b)
#pragma unroll
                for (int m = 0; m < 4; ++m)
#pragma unroll
                    for (int n = 0; n < 2; ++n) acc[a][b][m][n] = (f32x4){0.f, 0.f, 0.f, 0.f};
        cur = nxt; cA = nA; cB = nB; ++ui;
        if constexpr (ALIGN_EPI) { if (wr == 1) PG8_BAR; }
    }
    PG8_WAIT_V(0);
    if constexpr (!ALIGN_EPI) { if (wr == 0) PG8_BAR; }
    PG8_BAR;
#undef PG8_SA
#undef PG8_SB
#undef PG8_STAGE
#undef PG8_LDA
#undef PG8_LDB
#undef PG8_MMA
#undef PG8_WAIT_V
#undef PG8_WAIT_L
#undef PG8_BAR
#undef PG8_SCHED
}
}

__device__ __forceinline__ void p0_transpose_item(const float* W, int K, int N, bf16_t* WT, LAS float* scr, int item, int lane) {
    const int nblk = N / 32, kb = item / nblk, nb = item % nblk, k0 = 64 * kb, n0 = 32 * nb;
#pragma unroll 8
    for (int i = 0; i < 32; ++i) { const int kk = 2 * i + (lane >> 5); scr[kk * 33 + (lane & 31)] = W[(size_t)(k0 + kk) * N + n0 + (lane & 31)]; }
    asm volatile("s_waitcnt lgkmcnt(0)" ::: "memory");
    const int c = lane & 7;
#pragma unroll
    for (int j = 0; j < 4; ++j) { const int n = (lane >> 3) + 8 * j; const LAS float* s = scr + (8 * c) * 33 + n;
        v4u o; o.x = pk2(s[0 * 33], s[1 * 33]); o.y = pk2(s[2 * 33], s[3 * 33]); o.z = pk2(s[4 * 33], s[5 * 33]); o.w = pk2(s[6 * 33], s[7 * 33]);
        *(v4u*)(WT + (size_t)(n0 + n) * K + k0 + 8 * c) = o; }
    asm volatile("s_waitcnt lgkmcnt(0)" ::: "memory");
}
__device__ __forceinline__ void sincos_d(float ang, float& sn, float& cs) {
    const double x = (double)ang; const double n = __builtin_rint(x * 0.63661977236758134308); const double r = x - n * 1.57079632679489661923;
    const double r2 = r * r;
    const double s = r * (1.0 + r2 * (-1.0 / 6 + r2 * (1.0 / 120 + r2 * (-1.0 / 5040 + r2 * (1.0 / 362880 + r2 * (-1.0 / 39916800 + r2 * (1.0 / 6227020800.0)))))));
    const double c = 1.0 + r2 * (-0.5 + r2 * (1.0 / 24 + r2 * (-1.0 / 720 + r2 * (1.0 / 40320 + r2 * (-1.0 / 3628800 + r2 * (1.0 / 479001600.0))))));
    const int q = ((int)n) & 3;
    const double ss = (q == 0) ? s : (q == 1) ? c : (q == 2) ? -s : -c;
    const double cc = (q == 0) ? c : (q == 1) ? -s : (q == 2) ? -c : s;
    sn = (float)ss; cs = (float)cc;
}
__device__ __forceinline__ void phase0(const Args& args, Frame& F) {
    const float* const pin1 = args.in[opq(1)];
    const float* const pin3 = args.in[opq(3)];
    const float* const pin4 = args.in[opq(4)];
    const float* const pin5 = args.in[opq(5)];
    const float* const pin7 = args.in[opq(7)];
    const float* const pin9 = args.in[opq(9)];
    const float* const pin11 = args.in[opq(11)];
    const float* const pin17 = args.in[opq(17)];
    const float* const pin19 = args.in[opq(19)];
    const float* const pin20 = args.in[opq(20)];
    LAS float* scr = (LAS float*)(F.lds + F.wave * 16384);
    constexpr int I_IN = (D / 64) * (INW / 32), I_UQ = (QLORA / 64) * (768 / 32), I_UKV = (KVLORA / 64) * (1024 / 32), I_OUT = (D / 64) * (D / 32), I_1 = (D / 64) * (FF / 32), I_2 = (FF / 64) * (D / 32);
    constexpr int NITEMS = I_IN + I_UQ + I_UKV + I_OUT + I_1 + I_2;
    for (int it = F.gw; it < NITEMS; it += F.ngw) {
        int r = it;
        if (r < I_IN) { p0_transpose_item(pin7, D, INW, ((bf16_t*)(args.ws + WS_WIN)), scr, r, F.lane); continue; } r -= I_IN;
        if (r < I_UQ) { p0_transpose_item(pin9, QLORA, 768, ((bf16_t*)(args.ws + WS_WUQ)), scr, r, F.lane); continue; } r -= I_UQ;
        if (r < I_UKV) { p0_transpose_item(pin11, KVLORA, 1024, ((bf16_t*)(args.ws + WS_WUKV)), scr, r, F.lane); continue; } r -= I_UKV;
        if (r < I_OUT) { p0_transpose_item(pin17, D, D, ((bf16_t*)(args.ws + WS_WOUT)), scr, r, F.lane); continue; } r -= I_OUT;
        if (r < I_1) { p0_transpose_item(pin19, D, FF, ((bf16_t*)(args.ws + WS_W1)), scr, r, F.lane); continue; } r -= I_1;
        p0_transpose_item(pin20, FF, D, ((bf16_t*)(args.ws + WS_W2)), scr, r, F.lane);
    }
    { const int gt = F.bid * NTHREADS + F.tid, ngt = F.G * NTHREADS; v4u z = (v4u){0u, 0u, 0u, 0u};
      for (int i = gt; i < (INWP - INW) * D / 8; i += ngt) *(v4u*)(((bf16_t*)(args.ws + WS_WIN)) + (size_t)INW * D + (size_t)i * 8) = z; }
    { const int gt = F.bid * NTHREADS + F.tid, ngt = F.G * NTHREADS;
      for (int i = gt; i < SEQ * 32; i += ngt) { const int s = i >> 5, j = i & 31; const int row = s >> 6, col = s & 63; const int f = j & 15;
          const float inv = powf(10000.0f, -(float)f / 16.0f); const float ang = (j < 16 ? (float)row : (float)col) * inv; float sn, cs; sincos_d(ang, sn, cs); ((float*)(args.ws + WS_ROPE))[i] = cs; ((float*)(args.ws + WS_ROPE) + SEQ * 32)[i] = sn; }
      for (int i = gt; i < SEQ * 16; i += ngt) { const int s = i >> 4, j = i & 15; const int row = s >> 6, col = s & 63; const int f = j & 7;
          const float inv = powf(10000.0f, -(float)f / 8.0f); const float ang = (j < 8 ? (float)row : (float)col) * inv; float sn, cs; sincos_d(ang, sn, cs); ((float*)(args.ws + WS_ROPE) + SEQ * 64)[i] = cs; ((float*)(args.ws + WS_ROPE) + SEQ * 80)[i] = sn; } }
    __syncthreads();
    if (F.bid < 96) {
        LAS float* sl = (LAS float*)F.lds;
        LAS float* red = sl + 5 * 1024;
        for (int i = F.tid; i < 5 * 1024; i += NTHREADS) { const int r = i >> 10, k = i & 1023; const float v = (r < 4) ? pin1[r * 1024 + k] : pin3[k]; sl[i] = v / (1.0f + __expf(-v)); }
        __syncthreads();
        const int col = F.bid * 64 + F.lane; float a0 = 0.f, a1 = 0.f, a2 = 0.f, a3 = 0.f, a4 = 0.f;
        const int kb = F.wave * 128;
#pragma unroll 8
        for (int k = kb; k < kb + 128; ++k) { const float w = pin4[(size_t)k * 6144 + col];
            a0 += sl[k] * w; a1 += sl[1024 + k] * w; a2 += sl[2048 + k] * w; a3 += sl[3072 + k] * w; a4 += sl[4096 + k] * w; }
        red[(F.wave * 5 + 0) * 64 + F.lane] = a0; red[(F.wave * 5 + 1) * 64 + F.lane] = a1; red[(F.wave * 5 + 2) * 64 + F.lane] = a2; red[(F.wave * 5 + 3) * 64 + F.lane] = a3; red[(F.wave * 5 + 4) * 64 + F.lane] = a4;
        __syncthreads();
        if (F.tid < 320) { const int r = F.tid >> 6, l = F.tid & 63; float s = 0.f;
#pragma unroll
            for (int w = 0; w < 8; ++w) s += red[(w * 5 + r) * 64 + l];
            ((float*)(args.ws + WS_MODF))[r * 6144 + F.bid * 64 + l] = s + pin5[F.bid * 64 + l]; }
    }
    __syncthreads();
}

__device__ __forceinline__ void modulate_row(const float* xrow, const float* g, const float* shift, const float* scale, bf16_t* orow, int lane) {
    const f32x4* xr = (const f32x4*)xrow + lane;
    f32x4 v[4]; float s = 0.f;
#pragma unroll
    for (int j = 0; j < 4; ++j) { v[j] = xr[64 * j]; s += (v[j].x * v[j].x + v[j].y * v[j].y) + (v[j].z * v[j].z + v[j].w * v[j].w); }
    const float rstd = 1.0f / sqrtf(wave_sum(s) * (1.f / D) + EPS);
    v2u* o8 = (v2u*)orow + lane;
#pragma unroll
    for (int j = 0; j < 4; ++j) { const int c = 4 * lane + 256 * j; const f32x4 gg = *(const f32x4*)(g + c), sh = *(const f32x4*)(shift + c), sc = *(const f32x4*)(scale + c);
        const f32x4 y = v[j] * rstd * gg * (1.0f + sc) + sh; v2u w; w.x = pk2(y.x, y.y); w.y = pk2(y.z, y.w); o8[64 * j] = w; }
}
__device__ __forceinline__ void phase1(const Args& args, Frame& F) {
    const float* const pin0 = args.in[opq(0)];
    const float* const pin2 = args.in[opq(2)];
    const float* const pin6 = args.in[opq(6)];
    for (int m = F.gw; m < MA; m += F.ngw) {
        const bool lat = m < ML; const int r = lat ? (m >> 12) : 4;
        const float* src = lat ? pin0 + (size_t)m * D : pin2 + (size_t)(m - ML) * D;
        modulate_row(src, pin6, ((float*)(args.ws + WS_MODF)) + r * 6144, ((float*)(args.ws + WS_MODF)) + r * 6144 + 1024, ((bf16_t*)(args.ws + WS_H)) + (size_t)m * D, F.lane);
    }
}
__device__ __forceinline__ void phase8(const Args& args, Frame& F) {
    const float* const pin18 = args.in[opq(18)];
    for (int m = F.gw; m < ML; m += F.ngw) { const int r = m >> 12;
        modulate_row(args.out + (size_t)m * D, pin18, ((float*)(args.ws + WS_MODF)) + r * 6144 + 3072, ((float*)(args.ws + WS_MODF)) + r * 6144 + 4096, ((bf16_t*)(args.ws + WS_H)) + (size_t)m * D, F.lane); }
}

__device__ __forceinline__ int keyrow_of(int m) { return (m < ML) ? ((m >> 12) * NKEY + NCTX + (m & 4095)) : (((m - ML) >> 8) * NKEY + ((m - ML) & 255)); }

__device__ __forceinline__ void phase3(const Args& args, Frame& F) {
    const float* const pin8 = args.in[opq(8)];
    const float* const pin10 = args.in[opq(10)];
    const float* const pin14 = args.in[opq(14)];
    const float* const pin15 = args.in[opq(15)];
    const int lane = F.lane;
    for (int m = F.gw; m < MA; m += F.ngw) {
        const bf16_t* Zr = ((bf16_t*)(args.ws + WS_Z)) + (size_t)m * INWP; const bool lat = m < ML; const int s = m & 4095; const int kr = keyrow_of(m);
        { const v2u w = *(const v2u*)(Zr + Z_CQ + 4 * lane); const float c0 = bflo(w.x), c1 = bfhi(w.x), c2 = bflo(w.y), c3 = bfhi(w.y);
          const float ss = wave_sum(c0 * c0 + c1 * c1 + c2 * c2 + c3 * c3); const float r = 1.0f / sqrtf(ss * (1.f / 256) + EPS);
          if (lat) { const f32x4 g = *(const f32x4*)(pin8 + 4 * lane); v2u o; o.x = pk2(c0 * r * g.x, c1 * r * g.y); o.y = pk2(c2 * r * g.z, c3 * r * g.w); *(v2u*)(((bf16_t*)(args.ws + WS_A1Q)) + (size_t)m * 256 + 4 * lane) = o; } }
        { const unsigned w = *(const unsigned*)(Zr + Z_CKV + 2 * lane); const float c0 = bflo(w), c1 = bfhi(w);
          const float ss = wave_sum(c0 * c0 + c1 * c1); const float r = 1.0f / sqrtf(ss * (1.f / 128) + EPS);
          *(unsigned*)(((bf16_t*)(args.ws + WS_A1KV)) + (size_t)m * 128 + 2 * lane) = pk2(c0 * r * pin10[2 * lane], c1 * r * pin10[2 * lane + 1]); }
        const int i32 = lane & 31;
        const float cs = lat ? ((float*)(args.ws + WS_ROPE))[s * 32 + i32] : 1.f, sn = lat ? ((float*)(args.ws + WS_ROPE) + SEQ * 32)[s * 32 + i32] : 0.f;
        if (lat) {
            const float g = pin14[lane];
#pragma unroll
            for (int h = 0; h < SH; ++h) { const float v = bf2f(Zr[Z_QS + h * 64 + lane]); const float ss = wave_sum(v * v); const float y = v * (1.0f / sqrtf(ss * (1.f / 64) + EPS)) * g;
                const float p = __shfl_xor(y, 32); const float o = (lane < 32) ? (y * cs - p * sn) : (y * cs + p * sn);
                ((bf16_t*)(args.ws + WS_QS))[(size_t)m * 512 + h * 64 + lane] = (bf16_t)f2bf(o * SWA_C); }
        }
        { const float g = pin15[lane];
#pragma unroll
          for (int h = 0; h < SKV; ++h) { const float v = bf2f(Zr[Z_KS + h * 64 + lane]); const float ss = wave_sum(v * v); const float y = v * (1.0f / sqrtf(ss * (1.f / 64) + EPS)) * g;
              const float p = __shfl_xor(y, 32); const float o = (lane < 32) ? (y * cs - p * sn) : (y * cs + p * sn);
              ((bf16_t*)(args.ws + WS_KS))[(size_t)kr * 128 + h * 64 + lane] = (bf16_t)f2bf(o); }
          *(unsigned*)(((bf16_t*)(args.ws + WS_VS)) + (size_t)kr * 128 + 2 * lane) = *(const unsigned*)(Zr + Z_VS + 2 * lane); }
    }
}

__device__ __forceinline__ void phase5(const Args& args, Frame& F) {
    const float* const pin12 = args.in[opq(12)];
    const float* const pin13 = args.in[opq(13)];
    const int lane = F.lane;
    for (int m = F.gw; m < MA; m += F.ngw) {
        const bool lat = m < ML; const int s = m & 4095; const int kr = keyrow_of(m);
        const int i16 = lane & 15;
        const float cs = lat ? ((float*)(args.ws + WS_ROPE) + SEQ * 64)[s * 16 + i16] : 1.f, sn = lat ? ((float*)(args.ws + WS_ROPE) + SEQ * 80)[s * 16 + i16] : 0.f;
        if (lat) {
            const float g0 = pin12[lane], g1 = (lane < 32) ? pin12[64 + lane] : 0.f;
#pragma unroll
            for (int h = 0; h < MH; ++h) { const bf16_t* q = ((bf16_t*)(args.ws + WS_H)) + (size_t)m * 768 + h * 96;
                const float v0 = bf2f(q[lane]), v1 = (lane < 32) ? bf2f(q[64 + lane]) : 0.f;
                const float ss = wave_sum(v0 * v0 + v1 * v1); const float r = 1.0f / sqrtf(ss * (1.f / 96) + EPS);
                const float y0 = v0 * r * g0, y1 = v1 * r * g1; const float p = __shfl_xor(y1, 16);
                const float o1 = (lane < 16) ? (y1 * cs - p * sn) : (y1 * cs + p * sn);
                bf16_t* qo = ((bf16_t*)(args.ws + WS_QM)) + (size_t)m * 768 + h * 96; qo[lane] = (bf16_t)f2bf(y0 * MLA_C); if (lane < 32) qo[64 + lane] = (bf16_t)f2bf(o1 * MLA_C); }
        }
        { const float g0 = pin13[lane], g1 = (lane < 32) ? pin13[64 + lane] : 0.f;
          const float v1 = (lane < 32) ? bf2f(((bf16_t*)(args.ws + WS_Z))[(size_t)m * INWP + Z_KR + lane]) : 0.f;
#pragma unroll
          for (int h = 0; h < MH; ++h) { const bf16_t* kv = ((bf16_t*)(args.ws + WS_KVRAW)) + (size_t)m * 1024 + h * 128;
              const float v0 = bf2f(kv[lane]);
              const float ss = wave_sum(v0 * v0 + v1 * v1); const float r = 1.0f / sqrtf(ss * (1.f / 96) + EPS);
              const float y0 = v0 * r * g0, y1 = v1 * r * g1; const float p = __shfl_xor(y1, 16);
              const float o1 = (lane < 16) ? (y1 * cs - p * sn) : (y1 * cs + p * sn);
              bf16_t* ko = ((bf16_t*)(args.ws + WS_KM)) + (size_t)kr * 768 + h * 96; ko[lane] = (bf16_t)f2bf(y0); if (lane < 32) ko[64 + lane] = (bf16_t)f2bf(o1);
              ((bf16_t*)(args.ws + WS_VM))[(size_t)kr * 512 + h * 64 + lane] = kv[64 + lane]; } }
    }
}


namespace att {
typedef float f32x16 __attribute__((ext_vector_type(16)));
typedef short s16x4 __attribute__((ext_vector_type(4)));
#define SBAR() __builtin_amdgcn_sched_barrier(0)
constexpr float THR2 = 6.f;
constexpr int L_V = 0, L_K = 16384, L_WS = L_K + 2 * 64 * 208, L_OST = L_WS + 8 * 256, L_END = L_OST + 8 * 4096;
__device__ __forceinline__ int crow(int r, int hi) { return (r & 3) + 8 * (r >> 2) + 4 * hi; }
__device__ __forceinline__ unsigned cvtpk(float lo, float hi) { unsigned r; asm volatile("v_cvt_pk_bf16_f32 %0, %1, %2" : "=v"(r) : "v"(lo), "v"(hi)); return r; }
__device__ __forceinline__ void partialSM(f32x16& p0, f32x16& p1, float& m_reg, float& alpha) {
    float pmax = p0[0];
#pragma unroll
    for (int r = 1; r < 16; ++r) pmax = fmaxf(pmax, p0[r]);
#pragma unroll
    for (int r = 0; r < 16; ++r) pmax = fmaxf(pmax, p1[r]);
    { auto rr = __builtin_amdgcn_permlane32_swap(__float_as_uint(pmax), __float_as_uint(pmax), false, false); pmax = fmaxf(__uint_as_float(rr[0]), __uint_as_float(rr[1])); }
    float mn;
    if (__builtin_expect(__all(pmax - m_reg <= THR2), 1)) { mn = m_reg; alpha = 1.f; }
    else { mn = fmaxf(m_reg, pmax); alpha = __builtin_amdgcn_exp2f(m_reg - mn); m_reg = mn; }
#pragma unroll
    for (int r = 0; r < 16; ++r) p0[r] = p0[r] - mn;
#pragma unroll
    for (int r = 0; r < 16; ++r) p1[r] = p1[r] - mn;
#pragma unroll
    for (int r = 0; r < 16; ++r) p0[r] = __builtin_amdgcn_exp2f(p0[r]);
}
__device__ __forceinline__ void finishSM(f32x16& p0, f32x16& p1, float alpha, float& l_reg, bf16x8& pa0, bf16x8& pa1, bf16x8& pa2, bf16x8& pa3) {
#pragma unroll
    for (int r = 0; r < 16; ++r) p1[r] = __builtin_amdgcn_exp2f(p1[r]);
    float ps = 0.f;
#pragma unroll
    for (int r = 0; r < 16; ++r) ps += p0[r];
#pragma unroll
    for (int r = 0; r < 16; ++r) ps += p1[r];
    { auto rr = __builtin_amdgcn_permlane32_swap(__float_as_uint(ps), __float_as_uint(ps), false, false); ps = __uint_as_float(rr[0]) + __uint_as_float(rr[1]); }
    l_reg = l_reg * alpha + ps;
#define PK4(P, BASE, OUT) do { unsigned a0 = cvtpk(P[BASE + 0], P[BASE + 1]), a1 = cvtpk(P[BASE + 2], P[BASE + 3]);   \
    unsigned b0 = cvtpk(P[BASE + 4], P[BASE + 5]), b1 = cvtpk(P[BASE + 6], P[BASE + 7]);                              \
    auto r0 = __builtin_amdgcn_permlane32_swap(a0, b0, false, false); auto r1 = __builtin_amdgcn_permlane32_swap(a1, b1, false, false); \
    v4u w = {r0[0], r1[0], r0[1], r1[1]}; OUT = __builtin_bit_cast(bf16x8, w); } while (0)
    PK4(p0, 0, pa0); PK4(p0, 8, pa1); PK4(p1, 0, pa2); PK4(p1, 8, pa3);
#undef PK4
}
template <int ND, int KROW> __device__ __forceinline__ void qkt(f32x16& p0, f32x16& p1, const LAS unsigned char* Ks, const bf16x8* qr, int r32, int hi) {
    p0 = f32x16{}; p1 = f32x16{};
#pragma unroll
    for (int d0 = 0; d0 < ND; ++d0) { const int cb = (d0 * 16 + hi * 8) * 2;
        const bf16x8 b0 = *(const LAS bf16x8*)(Ks + r32 * KROW + cb);
        const bf16x8 b1 = *(const LAS bf16x8*)(Ks + (32 + r32) * KROW + cb);
        p0 = __builtin_amdgcn_mfma_f32_32x32x16_bf16(b0, qr[d0], p0, 0, 0, 0);
        p1 = __builtin_amdgcn_mfma_f32_32x32x16_bf16(b1, qr[d0], p1, 0, 0, 0); }
}
__device__ __forceinline__ int v_st(int k, int c) { const int kk = (k & ~0xC) | ((k & 4) << 1) | ((k & 8) >> 1); return ((kk >> 3) * 2 + (c >> 5)) * 512 + ((kk & 7) * 32 + (c & 31)) * 2; }
__device__ __forceinline__ int v_rd_base(int lane) { return ((lane & 3) << 3) | (((lane >> 2) & 3) << 6) | (((lane >> 4) & 1) << 5) | (((lane >> 5) & 1) << 8); }
constexpr int v_rd_off(int d0, int ks, int half) { return d0 * 512 + ks * 2048 + half * 1024; }
template <int OFF> __device__ __forceinline__ s16x4 tr_read(int vb) { s16x4 r; asm volatile("ds_read_b64_tr_b16 %0, %1 offset:%2" : "=&v"(r) : "v"(vb), "i"(OFF) : "memory"); return r; }
template <int D0> __device__ __forceinline__ void pv_one(f32x16& od, int vb, bf16x8 pa0, bf16x8 pa1, bf16x8 pa2, bf16x8 pa3) {
    const s16x4 l0 = tr_read<v_rd_off(D0, 0, 0)>(vb), h0 = tr_read<v_rd_off(D0, 0, 1)>(vb), l1 = tr_read<v_rd_off(D0, 1, 0)>(vb), h1 = tr_read<v_rd_off(D0, 1, 1)>(vb);
    const s16x4 l2 = tr_read<v_rd_off(D0, 2, 0)>(vb), h2 = tr_read<v_rd_off(D0, 2, 1)>(vb), l3 = tr_read<v_rd_off(D0, 3, 0)>(vb), h3 = tr_read<v_rd_off(D0, 3, 1)>(vb);
    asm volatile("s_waitcnt lgkmcnt(0)" ::: "memory"); SBAR();
#define PK(L, H) (bf16x8){L[0], L[1], L[2], L[3], H[0], H[1], H[2], H[3]}
    od = __builtin_amdgcn_mfma_f32_32x32x16_bf16(pa0, PK(l0, h0), od, 0, 0, 0);
    od = __builtin_amdgcn_mfma_f32_32x32x16_bf16(pa1, PK(l1, h1), od, 0, 0, 0);
    od = __builtin_amdgcn_mfma_f32_32x32x16_bf16(pa2, PK(l2, h2), od, 0, 0, 0);
    od = __builtin_amdgcn_mfma_f32_32x32x16_bf16(pa3, PK(l3, h3), od, 0, 0, 0);
#undef PK
}
__device__ __forceinline__ void pv2(f32x16* o, int vb, bf16x8 pa0, bf16x8 pa1, bf16x8 pa2, bf16x8 pa3) { pv_one<0>(o[0], vb, pa0, pa1, pa2, pa3); pv_one<1>(o[1], vb, pa0, pa1, pa2, pa3); }
__device__ __forceinline__ void band_mask(f32x16& p0, f32x16& p1, int kpos0, int qpos, int hi) {
#pragma unroll
    for (int r = 0; r < 16; ++r) { const int d0 = qpos - (kpos0 + crow(r, hi)), d1 = d0 - 32;
        if (d0 > 128 || d0 < -128) p0[r] = -1e30f; if (d1 > 128 || d1 < -128) p1[r] = -1e30f; }
}
template <int DQK, bool BAND, bool HAS_SINK>
__device__ __forceinline__ void attn_unit(const bf16_t* Qb, int ldq, const bf16_t* Kh, int ldk, const bf16_t* Vh, int ldv, bf16_t* Ob, int ldo,
                                          int NT, int nctx_t, int band_row0, int band_pos0, int qpos0, float sink_l2, LAS unsigned char* lds) {
    constexpr int ND = DQK / 16, KCH = DQK / 8, KROW = DQK * 2 + 16, KBUF = 64 * 208, VBUF = 8192;
    const int tid = threadIdx.x, wid = __builtin_amdgcn_readfirstlane(tid >> 6), lane = tid & 63, r32 = lane & 31, hi = lane >> 5;
    LAS unsigned char* V_lds = lds + L_V; LAS unsigned char* K_lds = lds + L_K;
    LAS float* wsf = (LAS float*)(lds + L_WS) + wid * 64; LAS float* li_l = wsf; LAS float* al_l = wsf + 32;
    float m_reg = -1e30f, l_reg = 0.f; f32x16 o[2]; o[0] = f32x16{}; o[1] = f32x16{}; bf16x8 qr[ND];
    const bf16_t* Qw = Qb + (size_t)(wid * 32 + r32) * ldq + hi * 8;
#pragma unroll
    for (int d0 = 0; d0 < ND; ++d0) qr[d0] = *(const bf16x8*)(Qw + d0 * 16);
    const int kc0 = tid, kr0 = kc0 / KCH, kh0 = kc0 % KCH;
    const int kc1 = (512 + tid < 64 * KCH) ? 512 + tid : 64 * KCH - 1, kr1 = kc1 / KCH, kh1 = kc1 % KCH;
    const bool k1on = (KCH > 8) && (tid < 64 * KCH - 512);
    const int vr = tid >> 3, vc = (tid & 7) * 8, vst = v_st(vr, vc);
    const int vb0 = (int)(unsigned)(uintptr_t)V_lds + v_rd_base(lane);
    const int qpos = qpos0 + wid * 32 + r32;
    struct { bf16x8 v, k0, k1; } sr_[2];
#define TROW(t) (((t) < nctx_t) ? 64 * (t) : band_row0 + 64 * ((t) - nctx_t))
#define SLOAD(i, t) do { const int k0_ = TROW(t); sr_[i].v = *(const bf16x8*)(Vh + (size_t)(k0_ + vr) * ldv + vc); \
    sr_[i].k0 = *(const bf16x8*)(Kh + (size_t)(k0_ + kr0) * ldk + kh0 * 8); if (KCH > 8) sr_[i].k1 = *(const bf16x8*)(Kh + (size_t)(k0_ + kr1) * ldk + kh1 * 8); } while (0)
#define SWRITE(b, i) do { *(LAS bf16x8*)(V_lds + (b) * VBUF + vst) = sr_[i].v; *(LAS bf16x8*)(K_lds + (b) * KBUF + kr0 * KROW + kh0 * 16) = sr_[i].k0; \
    if (KCH > 8) { if (k1on) *(LAS bf16x8*)(K_lds + (b) * KBUF + kr1 * KROW + kh1 * 16) = sr_[i].k1; } } while (0)
#define SWAIT() do { if (KCH > 8) asm volatile("s_waitcnt vmcnt(3)" ::: "memory"); else asm volatile("s_waitcnt vmcnt(2)" ::: "memory"); } while (0)
#define RESC(a) do { if (__any((a) < 1.f)) { if (hi == 0) al_l[r32] = (a); asm volatile("s_waitcnt lgkmcnt(0)" ::: "memory"); \
    _Pragma("unroll") for (int d = 0; d < 2; ++d) _Pragma("unroll") for (int r = 0; r < 16; ++r) o[d][r] *= al_l[crow(r, hi)]; } } while (0)
#define MASK(P0, P1, t) do { if (BAND) { if ((t) >= nctx_t) band_mask(P0, P1, band_pos0 + 64 * ((t) - nctx_t), qpos, hi); } } while (0)
    f32x16 pA0, pA1, pB0, pB1; float alA, alB; bf16x8 pa0, pa1, pa2, pa3;
    SLOAD(0, 0); asm volatile("s_waitcnt vmcnt(0)" ::: "memory"); SWRITE(0, 0); __syncthreads();
    qkt<ND, KROW>(pA0, pA1, K_lds, qr, r32, hi); MASK(pA0, pA1, 0); partialSM(pA0, pA1, m_reg, alA);
    SLOAD(1, 1); if (2 < NT) SLOAD(0, 2);
    SWAIT(); SWRITE(1, 1); __syncthreads();
    for (int j = 1; j + 1 < NT; j += 2) {
        SBAR(); qkt<ND, KROW>(pB0, pB1, K_lds + KBUF, qr, r32, hi); MASK(pB0, pB1, j);
        finishSM(pA0, pA1, alA, l_reg, pa0, pa1, pa2, pa3); SBAR();
        SLOAD(1, j + 2); SBAR();
        pv2(o, vb0, pa0, pa1, pa2, pa3); partialSM(pB0, pB1, m_reg, alB);
        __syncthreads(); SWAIT(); SWRITE(0, 0);
        RESC(alB); __syncthreads();
        SBAR(); qkt<ND, KROW>(pA0, pA1, K_lds, qr, r32, hi); MASK(pA0, pA1, j + 1);
        finishSM(pB0, pB1, alB, l_reg, pa0, pa1, pa2, pa3); SBAR();
        if (j + 3 < NT) SLOAD(0, j + 3); SBAR();
        pv2(o, vb0 + VBUF, pa0, pa1, pa2, pa3); partialSM(pA0, pA1, m_reg, alA);
        __syncthreads(); SWAIT(); SWRITE(1, 1);
        RESC(alA); __syncthreads();
    }
    SBAR(); qkt<ND, KROW>(pB0, pB1, K_lds + KBUF, qr, r32, hi); MASK(pB0, pB1, NT - 1);
    finishSM(pA0, pA1, alA, l_reg, pa0, pa1, pa2, pa3); SBAR();
    pv2(o, vb0, pa0, pa1, pa2, pa3); partialSM(pB0, pB1, m_reg, alB);
    __syncthreads(); RESC(alB);
    finishSM(pB0, pB1, alB, l_reg, pa0, pa1, pa2, pa3); SBAR();
    pv2(o, vb0 + VBUF, pa0, pa1, pa2, pa3);
    float fin = 1.f;
    if (HAS_SINK) { const float mn = fmaxf(m_reg, sink_l2); const float a = __builtin_amdgcn_exp2f(m_reg - mn); l_reg = l_reg * a + __builtin_amdgcn_exp2f(sink_l2 - mn); fin = a; }
    if (hi == 0) li_l[r32] = fin / l_reg;
    asm volatile("s_waitcnt lgkmcnt(0)" ::: "memory");
    float rli[16];
#pragma unroll
    for (int r = 0; r < 16; ++r) rli[r] = li_l[crow(r, hi)];
    { LAS bf16_t* stg = (LAS bf16_t*)(lds + L_OST) + wid * 2048;
#pragma unroll
      for (int r = 0; r < 16; ++r) { const int orow = crow(r, hi);
#pragma unroll
          for (int d0 = 0; d0 < 2; ++d0) stg[orow * 64 + d0 * 32 + r32] = (bf16_t)f2bf(o[d0][r] * rli[r]); }
      asm volatile("s_waitcnt lgkmcnt(0)" ::: "memory");
      bf16_t* Ow = Ob + (size_t)(wid * 32) * ldo;
#pragma unroll
      for (int i = 0; i < 4; ++i) { const int row = i * 8 + (lane >> 3), ch = lane & 7; const v4u v = *(const LAS v4u*)(stg + row * 64 + ch * 8); *(v4u*)(Ow + (size_t)row * ldo + ch * 8) = v; } }
    __syncthreads();
#undef TROW
#undef SLOAD
#undef SWRITE
#undef SWAIT
#undef RESC
#undef MASK
}
#undef SBAR
}

__device__ __forceinline__ void phase6_mla(const Args& args, Frame& F) {
    const int lane = F.lane;
    for (int it = F.gw; it < NB * MH * (SEQ / 64); it += F.ngw) {
        const int b = it / (MH * 64), h = (it / 64) % MH, qc = it % 64; const int m = b * SEQ + qc * 64 + lane;
        float q[96];
        { const v4u* qp = (const v4u*)(((bf16_t*)(args.ws + WS_QM)) + (size_t)m * 768 + h * 96);
#pragma unroll
          for (int c = 0; c < 12; ++c) { const v4u w = qp[c]; q[8 * c + 0] = bflo(w.x); q[8 * c + 1] = bfhi(w.x); q[8 * c + 2] = bflo(w.y); q[8 * c + 3] = bfhi(w.y); q[8 * c + 4] = bflo(w.z); q[8 * c + 5] = bfhi(w.z); q[8 * c + 6] = bflo(w.w); q[8 * c + 7] = bfhi(w.w); } }
        float o[64];
#pragma unroll
        for (int d = 0; d < 64; ++d) o[d] = 0.f;
        float mrun = -1e30f, l = 0.f;
        const bf16_t* Kb = ((bf16_t*)(args.ws + WS_KM)) + (size_t)b * NKEY * 768 + h * 96; const bf16_t* Vb = ((bf16_t*)(args.ws + WS_VM)) + (size_t)b * NKEY * 512 + h * 64;
#pragma unroll 1
        for (int j = 0; j < NKEY; ++j) {
            const v4u* kp = (const v4u*)(Kb + (size_t)j * 768); float a = 0.f;
#pragma unroll
            for (int c = 0; c < 12; ++c) { const v4u w = kp[c]; a += q[8 * c + 0] * bflo(w.x) + q[8 * c + 1] * bfhi(w.x) + q[8 * c + 2] * bflo(w.y) + q[8 * c + 3] * bfhi(w.y) + q[8 * c + 4] * bflo(w.z) + q[8 * c + 5] * bfhi(w.z) + q[8 * c + 6] * bflo(w.w) + q[8 * c + 7] * bfhi(w.w); }
            const float mn = fmaxf(a, mrun); const float al = __builtin_amdgcn_exp2f(mrun - mn); const float p = __builtin_amdgcn_exp2f(a - mn); l = l * al + p;
            const v4u* vp = (const v4u*)(Vb + (size_t)j * 512);
#pragma unroll
            for (int c = 0; c < 8; ++c) { const v4u w = vp[c]; o[8 * c + 0] = o[8 * c + 0] * al + p * bflo(w.x); o[8 * c + 1] = o[8 * c + 1] * al + p * bfhi(w.x); o[8 * c + 2] = o[8 * c + 2] * al + p * bflo(w.y); o[8 * c + 3] = o[8 * c + 3] * al + p * bfhi(w.y);
                o[8 * c + 4] = o[8 * c + 4] * al + p * bflo(w.z); o[8 * c + 5] = o[8 * c + 5] * al + p * bfhi(w.z); o[8 * c + 6] = o[8 * c + 6] * al + p * bflo(w.w); o[8 * c + 7] = o[8 * c + 7] * al + p * bfhi(w.w); }
            mrun = mn;
        }
        const float il = 1.0f / l; v4u* op = (v4u*)(((bf16_t*)(args.ws + WS_KVRAW)) + (size_t)m * 1024 + h * 64);
#pragma unroll
        for (int c = 0; c < 8; ++c) { v4u w; w.x = pk2(o[8 * c] * il, o[8 * c + 1] * il); w.y = pk2(o[8 * c + 2] * il, o[8 * c + 3] * il); w.z = pk2(o[8 * c + 4] * il, o[8 * c + 5] * il); w.w = pk2(o[8 * c + 6] * il, o[8 * c + 7] * il); op[c] = w; }
    }
}
__device__ __forceinline__ void phase6_swa(const Args& args, Frame& F) {
    const float* const pin16 = args.in[opq(16)];
    const int lane = F.lane;
    for (int it = F.gw; it < NB * SH * (SEQ / 64); it += F.ngw) {
        const int b = it / (SH * 64), h = (it / 64) % SH, qc = it % 64; const int q0 = qc * 64, qi = q0 + lane; const int m = b * SEQ + qi; const int kvh = h >> 2;
        float q[64];
        { const v4u* qp = (const v4u*)(((bf16_t*)(args.ws + WS_QS)) + (size_t)m * 512 + h * 64);
#pragma unroll
          for (int c = 0; c < 8; ++c) { const v4u w = qp[c]; q[8 * c + 0] = bflo(w.x); q[8 * c + 1] = bfhi(w.x); q[8 * c + 2] = bflo(w.y); q[8 * c + 3] = bfhi(w.y); q[8 * c + 4] = bflo(w.z); q[8 * c + 5] = bfhi(w.z); q[8 * c + 6] = bflo(w.w); q[8 * c + 7] = bfhi(w.w); } }
        float o[64];
#pragma unroll
        for (int d = 0; d < 64; ++d) o[d] = 0.f;
        float mrun = -1e30f, l = 0.f;
        const bf16_t* Kb = ((bf16_t*)(args.ws + WS_KS)) + (size_t)b * NKEY * 128 + kvh * 64; const bf16_t* Vb = ((bf16_t*)(args.ws + WS_VS)) + (size_t)b * NKEY * 128 + kvh * 64;
        const int lo = (q0 - 128 > 0) ? q0 - 128 : 0, hi = (q0 + 63 + 128 < SEQ - 1) ? q0 + 63 + 128 : SEQ - 1;
        const int nband = hi - lo + 1, ntot = NCTX + nband;
#pragma unroll 1
        for (int j = 0; j < ntot; ++j) {
            const int key = (j < NCTX) ? j : (NCTX + lo + (j - NCTX));
            const int kpos = (j < NCTX) ? qi : (lo + (j - NCTX));
            const int dlt = qi - kpos; const bool valid = (dlt <= 128) && (dlt >= -128);
            const v4u* kp = (const v4u*)(Kb + (size_t)key * 128); float a = 0.f;
#pragma unroll
            for (int c = 0; c < 8; ++c) { const v4u w = kp[c]; a += q[8 * c + 0] * bflo(w.x) + q[8 * c + 1] * bfhi(w.x) + q[8 * c + 2] * bflo(w.y) + q[8 * c + 3] * bfhi(w.y) + q[8 * c + 4] * bflo(w.z) + q[8 * c + 5] * bfhi(w.z) + q[8 * c + 6] * bflo(w.w) + q[8 * c + 7] * bfhi(w.w); }
            if (!valid) a = -1e30f;
            const float mn = fmaxf(a, mrun); const float al = __builtin_amdgcn_exp2f(mrun - mn); const float p = valid ? __builtin_amdgcn_exp2f(a - mn) : 0.f; l = l * al + p;
            const v4u* vp = (const v4u*)(Vb + (size_t)key * 128);
#pragma unroll
            for (int c = 0; c < 8; ++c) { const v4u w = vp[c]; o[8 * c + 0] = o[8 * c + 0] * al + p * bflo(w.x); o[8 * c + 1] = o[8 * c + 1] * al + p * bfhi(w.x); o[8 * c + 2] = o[8 * c + 2] * al + p * bflo(w.y); o[8 * c + 3] = o[8 * c + 3] * al + p * bfhi(w.y);
                o[8 * c + 4] = o[8 * c + 4] * al + p * bflo(w.z); o[8 * c + 5] = o[8 * c + 5] * al + p * bfhi(w.z); o[8 * c + 6] = o[8 * c + 6] * al + p * bflo(w.w); o[8 * c + 7] = o[8 * c + 7] * al + p * bfhi(w.w); }
            mrun = mn;
        }
        { const float a = pin16[h] * LOG2E; const float mn = fmaxf(a, mrun); const float al = __builtin_amdgcn_exp2f(mrun - mn); l = l * al + __builtin_amdgcn_exp2f(a - mn);
#pragma unroll
          for (int d = 0; d < 64; ++d) o[d] *= al; }
        const float il = 1.0f / l; v4u* op = (v4u*)(((bf16_t*)(args.ws + WS_KVRAW)) + (size_t)m * 1024 + 512 + h * 64);
#pragma unroll
        for (int c = 0; c < 8; ++c) { v4u w; w.x = pk2(o[8 * c] * il, o[8 * c + 1] * il); w.y = pk2(o[8 * c + 2] * il, o[8 * c + 3] * il); w.z = pk2(o[8 * c + 4] * il, o[8 * c + 5] * il); w.w = pk2(o[8 * c + 6] * il, o[8 * c + 7] * il); op[c] = w; }
    }
}


__device__ __forceinline__ void phase6_fast(const Args& args, Frame& F) {
    const int vcu = (F.G % 8 == 0) ? (F.bid % 8) * (F.G / 8) + F.bid / 8 : F.bid;
    bf16_t* MIXp = (bf16_t*)(args.ws + WS_KVRAW);
    for (int u = vcu; u < NB * MH * 16; u += F.G) {
        const int bh = u >> 4, qb = u & 15, b = bh >> 3, h = bh & 7;
        att::attn_unit<96, false, false>((const bf16_t*)(args.ws + WS_QM) + (size_t)(b * SEQ + qb * 256) * 768 + h * 96, 768,
            (const bf16_t*)(args.ws + WS_KM) + (size_t)b * NKEY * 768 + h * 96, 768, (const bf16_t*)(args.ws + WS_VM) + (size_t)b * NKEY * 512 + h * 64, 512,
            MIXp + (size_t)(b * SEQ + qb * 256) * 1024 + h * 64, 1024, NKEY / 64, NKEY / 64, 0, 0, 0, 0.f, F.lds);
    }
    const float* sink = args.in[opq(16)];
    for (int u = vcu; u < NB * SH * 16; u += F.G) {
        const int bh = u >> 4, qb = u & 15, b = bh >> 3, h = bh & 7;
        const int lo = (qb * 256 - 128 > 0) ? qb * 256 - 128 : 0, hi_ = (qb * 256 + 384 < SEQ) ? qb * 256 + 384 : SEQ;
        const int nband = (hi_ - lo) / 64;
        att::attn_unit<64, true, true>((const bf16_t*)(args.ws + WS_QS) + (size_t)(b * SEQ + qb * 256) * 512 + h * 64, 512,
            (const bf16_t*)(args.ws + WS_KS) + (size_t)b * NKEY * 128 + (h >> 2) * 64, 128, (const bf16_t*)(args.ws + WS_VS) + (size_t)b * NKEY * 128 + (h >> 2) * 64, 128,
            MIXp + (size_t)(b * SEQ + qb * 256) * 1024 + 512 + h * 64, 1024, 4 + nband, 4, NCTX + lo, lo, qb * 256, sink[h] * LOG2E, F.lds);
    }
}

constexpr int NPHASE = 11;
__global__ void __launch_bounds__(NTHREADS, 2) fwd_kernel(Args args) {
    extern __shared__ __attribute__((aligned(16))) unsigned char lds_raw[];
    Frame F;
    F.lds = (LAS unsigned char*)lds_raw;
    F.tid = threadIdx.x; F.lane = F.tid & 63; F.wave = __builtin_amdgcn_readfirstlane(F.tid >> 6);
    F.G = gridDim.x; F.bid = blockIdx.x; F.gw = F.bid * NWAVES + F.wave; F.ngw = F.G * NWAVES;
    unsigned char* ws = args.ws;
    volatile LAS unsigned* MISC = (volatile LAS unsigned*)(F.lds + MISC_OFF);
    for (int u = F.tid; u < 64; u += NTHREADS) MISC[u] = 0u;
    __syncthreads();
    unsigned* ctl = (unsigned*)(ws + WS_CTL);
    XcdBarrier bar; bar.bar = ctl + CW_BAR; bar.x = 0; bar.st = nullptr;
    if (MK_N_LAUNCHES == 1) bar = xcd_barrier_post(ctl + CW_BAR, MISC + 8);
    const int lo = args.ph_lo, hi = args.ph_hi;
#define IN(k) (lo <= (k) && (k) < hi)
#define SEAM(k) do { if (IN(k) && IN((k) + 1)) xcd_barrier(bar); } while (0)
    if (IN(0)) { phase0(args, F); } SEAM(0);
    if (IN(1)) { phase1(args, F); } SEAM(1);
    if (IN(2)) { pg8::Gemm g{((bf16_t*)(args.ws + WS_H)), ((bf16_t*)(args.ws + WS_WIN)), MA, INWP, D}; pg8::StaticOrder S; S.init(MA, INWP, F.G, F.bid); pg8::EpiBf16<0> E{((bf16_t*)(args.ws + WS_Z)), INWP};
                 pg8::gemm_phase<pg8::EpiBf16<0>, pg8::StaticOrder, true, true>(F.lds, g, S, E); } SEAM(2);
    if (IN(3)) { phase3(args, F); } SEAM(3);
    if (IN(4)) { { pg8::Gemm g{((bf16_t*)(args.ws + WS_A1Q)), ((bf16_t*)(args.ws + WS_WUQ)), ML, 768, QLORA}; pg8::StaticOrder S; S.init(ML, 768, F.G, F.bid); pg8::EpiBf16<0> E{((bf16_t*)(args.ws + WS_H)), 768};
                   pg8::gemm_phase<pg8::EpiBf16<0>, pg8::StaticOrder, true, true>(F.lds, g, S, E); } }
    if (IN(4)) { { pg8::Gemm g{((bf16_t*)(args.ws + WS_A1KV)), ((bf16_t*)(args.ws + WS_WUKV)), MA, 1024, opq(KVLORA)}; pg8::StaticOrder S; S.init(MA, 1024, F.G, F.bid); pg8::EpiBf16<0> E{((bf16_t*)(args.ws + WS_KVRAW)), 1024};
                   pg8::gemm_phase<pg8::EpiBf16<0>, pg8::StaticOrder, true, true>(F.lds, g, S, E); } } SEAM(4);
    if (IN(5)) { phase5(args, F); } SEAM(5);
    if (IN(6)) { phase6_fast(args, F); } SEAM(6);
    if (IN(7)) { pg8::Gemm g{((bf16_t*)(args.ws + WS_KVRAW)), ((bf16_t*)(args.ws + WS_WOUT)), ML, D, D}; pg8::StaticOrder S; S.init(ML, D, F.G, F.bid); pg8::EpiGate E{args.in[opq(0)], args.out, ((float*)(args.ws + WS_MODF)) + 2048};
                 pg8::gemm_phase<pg8::EpiGate, pg8::StaticOrder, true, true>(F.lds, g, S, E); } SEAM(7);
    if (IN(8)) { phase8(args, F); } SEAM(8);
    if (IN(9)) { pg8::Gemm g{((bf16_t*)(args.ws + WS_H)), ((bf16_t*)(args.ws + WS_W1)), ML, FF, D}; pg8::StaticOrder S; S.init(ML, FF, F.G, F.bid); pg8::EpiBf16<1> E{((bf16_t*)(args.ws + WS_ACT)), FF};
                 pg8::gemm_phase<pg8::EpiBf16<1>, pg8::StaticOrder, true, true>(F.lds, g, S, E); } SEAM(9);
    if (IN(10)) { pg8::Gemm g{((bf16_t*)(args.ws + WS_ACT)), ((bf16_t*)(args.ws + WS_W2)), ML, D, FF}; pg8::StaticOrder S; S.init(ML, D, F.G, F.bid); pg8::EpiGate E{args.out, args.out, ((float*)(args.ws + WS_MODF)) + 5120};
                  pg8::gemm_phase<pg8::EpiGate, pg8::StaticOrder, true, true>(F.lds, g, S, E); }
#undef IN
#undef SEAM
}

extern "C" void kernel_launch(void* const* d_in, const int* in_sizes, int n_in, void* d_out, int out_size, void* d_ws, size_t ws_size, hipStream_t stream) {
    static int grid = 0;
    if (grid == 0) {
        if (n_in != 21 || out_size != ML * D || ws_size < WS_END) { fprintf(stderr, "kernel_launch: unexpected problem shape (n_in %d, out %d, ws %zu)\n", n_in, out_size, ws_size); grid = -1; return; }
        int dev = 0, cus = 0, per_cu = 0;
        if (hipGetDevice(&dev) != hipSuccess || hipDeviceGetAttribute(&cus, hipDeviceAttributeMultiprocessorCount, dev) != hipSuccess) { grid = -1; return; }
        if (hipFuncSetAttribute((const void*)fwd_kernel, hipFuncAttributeMaxDynamicSharedMemorySize, LDS_BYTES) != hipSuccess) { fprintf(stderr, "kernel_launch: hipFuncSetAttribute failed\n"); grid = -1; return; }
        if (hipOccupancyMaxActiveBlocksPerMultiprocessor(&per_cu, (const void*)fwd_kernel, NTHREADS, LDS_BYTES) != hipSuccess || per_cu < 1) { fprintf(stderr, "kernel_launch: occupancy query says %d\n", per_cu); }
        (void)hipGetLastError();
        grid = cus;
    }
    if (grid < 0) return;
    (void)hipMemsetAsync((char*)d_ws + WS_CTL, 0, CTL_ZERO_BYTES, stream);
    Args a{};
    for (int i = 0; i < 21; ++i) a.in[i] = (const float*)d_in[i];
    a.out = (float*)d_out; a.ws = (unsigned char*)d_ws;
    if (MK_N_LAUNCHES == 1) { a.ph_lo = 0; a.ph_hi = NPHASE; hipLaunchKernelGGL(fwd_kernel, dim3(grid), dim3(NTHREADS), LDS_BYTES, stream, a); }
    else { for (int p = 0; p < NPHASE; ++p) { a.ph_lo = p; a.ph_hi = p + 1; hipLaunchKernelGGL(fwd_kernel, dim3(grid), dim3(NTHREADS), LDS_BYTES, stream, a); } }
}
```
